# Optimizing an MI355X kernel written in HIP

```python
import math
import jax, jax.numpy as jnp
from jax import lax
import numpy as np

D_MODEL = 1024
BATCH = 4
SEQ = 8192
DEPTH = 1

N_META = 16
N_Q_HEADS = 8
N_KV_HEADS = 2
HEAD_DIM = 64
Q_GROUP = N_Q_HEADS // N_KV_HEADS
ATTN_DIM = N_Q_HEADS * HEAD_DIM
KV_DIM = N_KV_HEADS * HEAD_DIM
WINDOW = 128
BLK = 128
PAD = BLK - N_META
N_BUCKETS = 32
MAX_DISTANCE = 128
CONV_CH = D_MODEL // 2
CONV_W = 3
IN_PROJ = ATTN_DIM + 2 * KV_DIM + 3 * CONV_CH
MIX_DIM = ATTN_DIM + CONV_CH
SPLITS = (ATTN_DIM, ATTN_DIM + KV_DIM, ATTN_DIM + 2 * KV_DIM,
          ATTN_DIM + 2 * KV_DIM + CONV_CH, ATTN_DIM + 2 * KV_DIM + 2 * CONV_CH)
N_GROUPS = 4
EXPERTS_PER_GROUP = 8
N_EXPERTS = N_GROUPS * EXPERTS_PER_GROUP
TOP_K = 2
D_EXPERT = D_MODEL // 2
MOE_BLK = 128
EPS = 1e-6
NEG_INF = -1e30

kernel_name = 'hymba_swa_sink_shortconv_hier_moe'


def rms_norm(x, g):
    xf = x.astype(jnp.float32)
    y = xf * lax.rsqrt(jnp.mean(xf * xf, axis=-1, keepdims=True) + EPS)
    return y.astype(x.dtype) * g


def t5_causal_bucket(n):
    max_exact = N_BUCKETS // 2
    nf = jnp.maximum(n, 1).astype(jnp.float32)
    large = max_exact + (jnp.log(nf / max_exact) / math.log(MAX_DISTANCE / max_exact)
                         * (N_BUCKETS - max_exact)).astype(jnp.int32)
    large = jnp.minimum(large, N_BUCKETS - 1)
    return jnp.where(n < max_exact, n, large)


def band_bias_and_mask(rel_bias, n_blocks):
    qi = jnp.arange(BLK)[:, None]
    sj = jnp.arange(2 * BLK)[None, :]
    dist = BLK + qi - sj
    band = (dist >= 0) & (dist < WINDOW)
    bucket = t5_causal_bucket(jnp.maximum(dist, 0))
    bias = jnp.transpose(rel_bias[bucket].astype(jnp.float32), (2, 0, 1))
    bias = bias.reshape(N_KV_HEADS, Q_GROUP, BLK, 2 * BLK)
    key_pos = (jnp.arange(n_blocks)[:, None, None] - 1) * BLK + sj[None]
    mask = band[None] & (key_pos >= PAD)
    return bias, mask


def sliding_window_sink_attention(q, k, v, sinks, rel_bias):
    bsz, seq = q.shape[0], q.shape[1]
    lp = seq + PAD
    nb = lp // BLK
    pad = ((0, 0), (PAD, 0), (0, 0), (0, 0))
    q = jnp.pad(q, pad).reshape(bsz, nb, BLK, N_KV_HEADS, Q_GROUP, HEAD_DIM)
    k = jnp.pad(k, pad).reshape(bsz, nb, BLK, N_KV_HEADS, HEAD_DIM)
    v = jnp.pad(v, pad).reshape(bsz, nb, BLK, N_KV_HEADS, HEAD_DIM)
    prev = lambda t: jnp.pad(t, ((0, 0), (1, 0), (0, 0), (0, 0), (0, 0)))[:, :-1]
    kw = jnp.concatenate([prev(k), k], axis=2)
    vw = jnp.concatenate([prev(v), v], axis=2)
    bias, mask = band_bias_and_mask(rel_bias, nb)
    s = jnp.einsum('bnqkgd,bnskd->bnkgqs', q, kw).astype(jnp.float32) * (HEAD_DIM ** -0.5) + bias
    s = jnp.where(mask[None, :, None, None], s, NEG_INF)
    sink = sinks.astype(jnp.float32).reshape(1, 1, N_KV_HEADS, Q_GROUP, 1, 1)
    m = jnp.maximum(jnp.max(s, axis=-1, keepdims=True), sink)
    p = jnp.exp(s - m)
    p = p / (jnp.sum(p, axis=-1, keepdims=True) + jnp.exp(sink - m))
    o = jnp.einsum('bnkgqs,bnskd->bnqkgd', p.astype(v.dtype), vw)
    return o.reshape(bsz, lp, ATTN_DIM)[:, PAD:]


def short_gated_conv(b_gate, c_gate, h, conv_w):
    u = c_gate * h
    y = lax.conv_general_dilated(u, conv_w[:, None, :].astype(u.dtype), (1,), [(CONV_W - 1, 0)],
                                 dimension_numbers=('NWC', 'WIO', 'NWC'),
                                 feature_group_count=CONV_CH)
    return b_gate * y


def hierarchical_moe(xt, w_gr, b_gr, w_er, b_er, w_g, w_u, w_d):
    n_tok = xt.shape[0]
    xf = xt.astype(jnp.float32)
    g_prob = jax.nn.softmax(xf @ w_gr.astype(jnp.float32) + b_gr.astype(jnp.float32), axis=-1)
    g_p, g_idx = lax.top_k(g_prob, 1)
    e_logits = jnp.einsum('td,dge->tge', xf, w_er.astype(jnp.float32)) + b_er.astype(jnp.float32)
    e_logits = jnp.take_along_axis(e_logits, g_idx[:, :, None], axis=1)[:, 0]
    e_val, e_idx = lax.top_k(e_logits, TOP_K)
    gates = g_p * jax.nn.softmax(e_val, axis=-1)
    expert_id = g_idx * EXPERTS_PER_GROUP + e_idx
    n_asg = n_tok * TOP_K
    eid = expert_id.reshape(n_asg)
    order = jnp.argsort(eid)
    eid_s = eid[order]
    tok_s = order // TOP_K
    gate_s = gates.reshape(n_asg)[order]
    counts = jnp.bincount(eid, length=N_EXPERTS)
    padded = (counts + MOE_BLK - 1) // MOE_BLK * MOE_BLK
    pend = jnp.cumsum(padded)
    start = jnp.cumsum(counts) - counts
    dest = (pend - padded)[eid_s] + jnp.arange(n_asg) - start[eid_s]
    n_blocks = -(-n_asg // MOE_BLK) + N_EXPERTS
    xbuf = jnp.zeros((n_blocks * MOE_BLK, D_MODEL), xt.dtype).at[dest].set(xt[tok_s])
    block_e = jnp.minimum(jnp.searchsorted(pend, jnp.arange(n_blocks) * MOE_BLK, side='right'),
                          N_EXPERTS - 1)

    def expert_block(args):
        xb, e = args
        return (jax.nn.silu(xb @ w_g[e]) * (xb @ w_u[e])) @ w_d[e]

    ybuf = lax.map(expert_block, (xbuf.reshape(n_blocks, MOE_BLK, D_MODEL), block_e))
    y = ybuf.reshape(n_blocks * MOE_BLK, D_MODEL)[dest] * gate_s[:, None].astype(xt.dtype)
    return jax.ops.segment_sum(y, tok_s, num_segments=n_tok)


def setup_inputs(seed: int = 0) -> dict:
    key = jax.random.key(seed)
    ks = jax.random.split(key, 20)
    f32 = jnp.float32

    def nrm(k, shape, scale):
        return jax.random.normal(k, shape, f32) * scale

    def gain(k, shape):
        return 1.0 + 0.02 * jax.random.normal(k, shape, f32)

    return {
        'x': nrm(ks[0], (BATCH, SEQ, D_MODEL), 1.0),
        'meta_tokens': nrm(ks[1], (N_META, D_MODEL), 1.0),
        'rel_bias': nrm(ks[2], (N_BUCKETS, N_Q_HEADS), 0.2),
        'mix_norm_g': gain(ks[3], (DEPTH, D_MODEL)),
        'w_in': nrm(ks[4], (DEPTH, D_MODEL, IN_PROJ), D_MODEL ** -0.5),
        'q_norm_g': gain(ks[5], (DEPTH, HEAD_DIM)),
        'k_norm_g': gain(ks[6], (DEPTH, HEAD_DIM)),
        'attn_sinks': nrm(ks[7], (DEPTH, N_Q_HEADS), 0.5),
        'conv_w': nrm(ks[8], (DEPTH, CONV_W, CONV_CH), CONV_W ** -0.5),
        'attn_out_norm_g': gain(ks[9], (DEPTH, ATTN_DIM)),
        'conv_out_norm_g': gain(ks[10], (DEPTH, CONV_CH)),
        'w_out': nrm(ks[11], (DEPTH, MIX_DIM, D_MODEL), MIX_DIM ** -0.5),
        'ffn_norm_g': gain(ks[12], (DEPTH, D_MODEL)),
        'w_group_router': nrm(ks[13], (DEPTH, D_MODEL, N_GROUPS), D_MODEL ** -0.5),
        'b_group_router': nrm(ks[14], (DEPTH, N_GROUPS), 0.01),
        'w_expert_router': nrm(ks[15], (DEPTH, D_MODEL, N_GROUPS, EXPERTS_PER_GROUP), D_MODEL ** -0.5),
        'b_expert_router': nrm(ks[16], (DEPTH, N_GROUPS, EXPERTS_PER_GROUP), 0.01),
        'w_gate': nrm(ks[17], (DEPTH, N_EXPERTS, D_MODEL, D_EXPERT), D_MODEL ** -0.5),
        'w_up': nrm(ks[18], (DEPTH, N_EXPERTS, D_MODEL, D_EXPERT), D_MODEL ** -0.5),
        'w_down': nrm(ks[19], (DEPTH, N_EXPERTS, D_EXPERT, D_MODEL), D_EXPERT ** -0.5),
    }


def reference(x, meta_tokens, rel_bias, mix_norm_g, w_in, q_norm_g, k_norm_g, attn_sinks, conv_w,
              attn_out_norm_g, conv_out_norm_g, w_out, ffn_norm_g, w_group_router, b_group_router,
              w_expert_router, b_expert_router, w_gate, w_up, w_down):
    bsz = x.shape[0]
    meta = jnp.broadcast_to(meta_tokens.astype(x.dtype)[None], (bsz, N_META, D_MODEL))
    h = jnp.concatenate([meta, x], axis=1)
    seq = h.shape[1]
    for l in range(DEPTH):
        hn = rms_norm(h, mix_norm_g[l])
        proj = hn @ w_in[l]
        q, k, v, cb, cc, ch = jnp.split(proj, SPLITS, axis=-1)
        q = rms_norm(q.reshape(bsz, seq, N_Q_HEADS, HEAD_DIM), q_norm_g[l])
        k = rms_norm(k.reshape(bsz, seq, N_KV_HEADS, HEAD_DIM), k_norm_g[l])
        v = v.reshape(bsz, seq, N_KV_HEADS, HEAD_DIM)
        a = sliding_window_sink_attention(q, k, v, attn_sinks[l], rel_bias)
        c = short_gated_conv(cb, cc, ch, conv_w[l])
        mixed = jnp.concatenate([rms_norm(a, attn_out_norm_g[l]),
                                 rms_norm(c, conv_out_norm_g[l])], axis=-1)
        h = h + mixed @ w_out[l]
        hn = rms_norm(h, ffn_norm_g[l])
        y = hierarchical_moe(hn.reshape(bsz * seq, D_MODEL), w_group_router[l], b_group_router[l],
                             w_expert_router[l], b_expert_router[l], w_gate[l], w_up[l], w_down[l])
        h = h + y.reshape(bsz, seq, D_MODEL)
    return h[:, N_META:]
```

```cpp
#include <hip/hip_runtime.h>
#include <cstdio>
#include <cstdint>

#define LAS __attribute__((address_space(3)))
#define GAS __attribute__((address_space(1)))
typedef unsigned short bf16;
typedef short bf16x8 __attribute__((ext_vector_type(8)));
typedef float f32x4 __attribute__((ext_vector_type(4)));
typedef float f32x16 __attribute__((ext_vector_type(16)));
typedef unsigned u32x4 __attribute__((ext_vector_type(4)));
typedef unsigned u32x2 __attribute__((ext_vector_type(2)));
typedef float f32x2_t __attribute__((ext_vector_type(2)));
typedef __bf16 bf16x2_t __attribute__((ext_vector_type(2)));

constexpr int NB = 4, SEQ = 8192, D = 1024, NMETA = 16;
constexpr int MTOK = NB * SEQ;
constexpr int MROWS = MTOK + 256;
constexpr int NPROJ = 2304;
constexpr int COL_K = 512, COL_V = 640, COL_CB = 768, COL_CC = 1280, COL_CH = 1792;
constexpr int NEXP = 32, DEXP = 512, ECAP = 32768;
constexpr int MAXTILES = 288;
constexpr float EPS = 1e-6f;
constexpr float LOG2E = 1.4426950408889634f;

constexpr size_t MiB = 1u << 20;
constexpr size_t WS_CTL = 0, CTL_BYTES = 1 * MiB;
constexpr size_t WS_ROWTOK = 1 * MiB;
constexpr size_t WS_ROWRS = 5 * MiB;
constexpr size_t WS_ROWGATE = 9 * MiB;
constexpr size_t WS_TOKSLOT = 13 * MiB;
constexpr size_t WS_RSX = 13 * MiB + 512 * 1024;
constexpr size_t WS_WR = 14 * MiB;
constexpr size_t WS_WIN = 15 * MiB;
constexpr size_t WS_WOUT = 20 * MiB;
constexpr size_t WS_WGU = 22 * MiB;
constexpr size_t WS_WD = 86 * MiB;
constexpr size_t WS_XB = 118 * MiB;
constexpr size_t WS_PROJ = 184 * MiB;
constexpr size_t WS_HB = WS_PROJ;
constexpr size_t WS_HID = WS_PROJ + 64 * MiB;
constexpr size_t WS_YBUF = 332 * MiB;
constexpr size_t WS_END = 476 * MiB;
static_assert(WS_XB + (size_t)MROWS * D * 2 <= WS_PROJ && WS_PROJ + (size_t)MROWS * NPROJ * 2 <= WS_YBUF && WS_HID + (size_t)MAXTILES * 256 * DEXP * 2 <= WS_YBUF &&
              WS_YBUF + (size_t)MAXTILES * 256 * D * 2 <= WS_END, "d_ws map");
constexpr int CW_BAR = 4096;
constexpr int CW_CNT = 16384;

constexpr int LDS_BYTES = 147456;
constexpr int RING_BYTES = 131072;
constexpr int LDSCTL_OFF = 146432;
constexpr int MISC_BAR = 0, MISC_TSTART = 64, MISC_CNT = 256, MISC_LCNT = 384, MISC_LBASE = 512;
constexpr int KN_OFF = 0, KN_HEAD = 32768;
constexpr int VT_OFF = 65536, VT_ROW = 528, VT_HEAD = 64 * VT_ROW;
constexpr int BIAS_OFF = VT_OFF + 2 * VT_HEAD;
constexpr int SSA_OFF = BIAS_OFF + 4096;
static_assert(SSA_OFF + 4096 <= LDSCTL_OFF, "P2 LDS map");

__device__ __forceinline__ unsigned pk2(float lo, float hi) { f32x2_t v = {lo, hi}; bf16x2_t b = __builtin_convertvector(v, bf16x2_t); return __builtin_bit_cast(unsigned, b); }
__device__ __forceinline__ float bflo(unsigned w) { return __uint_as_float(w << 16); }
__device__ __forceinline__ float bfhi(unsigned w) { return __uint_as_float(w & 0xffff0000u); }
__device__ __forceinline__ float wave_sum(float v) {
#pragma unroll
    for (int o = 1; o < 64; o <<= 1) v += __shfl_xor(v, o);
    return v;
}
#define LDS_WAIT() asm volatile("s_waitcnt lgkmcnt(0)" ::: "memory")
#define VM_WAIT() asm volatile("s_waitcnt vmcnt(0)" ::: "memory")

#define XB_TMO      128
#define XB_XCNT(j)  (256  + 64 * (j))
#define XB_XSUB(j)  (1280 + 64 * (j))
#define XB_XGEN(j)  (2304 + 64 * (j))
#define XB_TOP      3328
#define XB_TOPGEN   3392
#define XCD_BAR_WORDS 3456
#define XB_SPIN_CAP (1u << 18)
__device__ __forceinline__ unsigned xb_ld(unsigned* p)              { return __hip_atomic_load(p, __ATOMIC_RELAXED, __HIP_MEMORY_SCOPE_AGENT); }
__device__ __forceinline__ unsigned xb_add(unsigned* p, unsigned v) { return __hip_atomic_fetch_add(p, v, __ATOMIC_RELAXED, __HIP_MEMORY_SCOPE_AGENT); }
__device__ __forceinline__ unsigned xb_xcc_id() { return (unsigned)__builtin_amdgcn_s_getreg((3 << 11) | 20) & 0xFu; }
#define XB_SPIN(cond, bar) do { unsigned _sp = 0; while (cond) { __builtin_amdgcn_s_sleep(1); \
    if ((++_sp & 255u) == 0u) { if (xb_ld(&(bar)[XB_TMO])) break; if (_sp > XB_SPIN_CAP) { atomicAdd(&(bar)[XB_TMO], 1u); break; } } } } while (0)
struct XcdBarrier { unsigned* bar; unsigned x; volatile LAS unsigned* st; };
__device__ __forceinline__ XcdBarrier xcd_barrier_post(unsigned* bar, volatile LAS unsigned* st) {
    XcdBarrier b; b.bar = bar; b.x = xb_xcc_id(); b.st = st;
    if (threadIdx.x == 0) (void)xb_add(&bar[XB_XCNT(b.x)], 1u);
    return b;
}
__device__ __forceinline__ void xcd_barrier_complete(unsigned* bar, unsigned x, unsigned& nloc, unsigned& nx) {
    const unsigned G = gridDim.x * gridDim.y * gridDim.z;
    unsigned sum, cnt, mine, sp = 0u;
    for (;;) {
        sum = 0u; cnt = 0u; mine = 0u;
#pragma unroll
        for (unsigned j = 0; j < 16; ++j) { const unsigned c = xb_ld(&bar[XB_XCNT(j)]); sum += c; cnt += (c > 0u) ? 1u : 0u; mine = (j == x) ? c : mine; }
        if (sum == G) break;
        __builtin_amdgcn_s_sleep(1);
        if ((++sp & 255u) == 0u) { if (xb_ld(&bar[XB_TMO])) break; if (sp > XB_SPIN_CAP) { atomicAdd(&bar[XB_TMO], 1u); break; } }
    }
    nloc = mine > 0u ? mine : 1u; nx = cnt > 0u ? cnt : 1u;
}
__device__ __forceinline__ void xcd_barrier(const XcdBarrier& b) {
    asm volatile("s_waitcnt vmcnt(0)" ::: "memory");
    __syncthreads();
    if (threadIdx.x == 0) {
        unsigned* bar = b.bar;
        __builtin_amdgcn_s_waitcnt(0);
        unsigned nloc = b.st[0], nx = b.st[1];
        if (nloc == 0u) { xcd_barrier_complete(bar, b.x, nloc, nx); b.st[0] = nloc; b.st[1] = nx; }
        const unsigned old = xb_add(&bar[XB_XSUB(b.x)], 1u);
        const unsigned gen = old / nloc;
        if (old + 1u == (gen + 1u) * nloc) {
            __builtin_amdgcn_fence(__ATOMIC_RELEASE, "agent");
            asm volatile("s_waitcnt vmcnt(0)" ::: "memory");
            const unsigned og = xb_add(&bar[XB_TOP], 1u);
            const unsigned tg = og / nx;
            if (og + 1u == (tg + 1u) * nx) xb_add(&bar[XB_TOPGEN], 1u);
            else XB_SPIN(xb_ld(&bar[XB_TOPGEN]) == tg, bar);
            __builtin_amdgcn_fence(__ATOMIC_ACQUIRE, "agent");
            xb_add(&bar[XB_XGEN(b.x)], 1u);
            asm volatile("s_waitcnt vmcnt(0)" ::: "memory");
        } else {
            XB_SPIN(xb_ld(&bar[XB_XGEN(b.x)]) == gen, bar);
            __builtin_amdgcn_fence(__ATOMIC_ACQUIRE, "agent");
            asm volatile("s_waitcnt vmcnt(0)" ::: "memory");
        }
    }
    __syncthreads();
}

namespace pg8 {
constexpr int BM = 256, BK = 64, HALF = 128, HTB = HALF * BK * 2, STAGE_BYTES = 8 * HTB, NXCD = 8, WGM = 8;
__host__ __device__ __forceinline__ int lds_byte(int r, int c) { const int st = (r >> 4) * 2 + (c >> 5), rr = r & 15, cc = c & 31, ob = rr * 64 + cc * 2; return st * 1024 + (ob ^ (((ob >> 9) & 1) << 5)); }
__host__ __device__ __forceinline__ void stage_rc(int b, int& R, int& C) { const int st = b / 1024, sb = b % 1024, swz = sb ^ (((sb >> 9) & 1) << 5); R = (st >> 1) * 16 + swz / 64; C = (st & 1) * 32 + (swz % 64) / 2; }
__host__ __device__ __forceinline__ int perm32(int rho) { const int n = rho >> 4, i = rho & 15; return 8 * (i >> 2) + 4 * n + (i & 3); }

struct Unit { int pm, pn, xa, xb; };
struct Gemm { const bf16* A; const bf16* Bt; int K; };

struct StaticOrder {
    int nM, nN, nwg, G, c, K;
    __device__ void init(int M, int N, int K_, int G_, int c_) { nM = M / BM; nN = N / BM; nwg = nM * nN; G = G_; c = c_; K = K_; }
    __device__ __forceinline__ bool next(int i, Unit& u) const {
        const long L = (long)i * G + c; if (L >= nwg) return false;
        int wgid = (int)L; { const int q = nwg / NXCD, r = nwg % NXCD, xcd = wgid % NXCD, off = wgid / NXCD; wgid = (xcd < r ? xcd * (q + 1) : r * (q + 1) + (xcd - r) * q) + off; }
        const int nig = WGM * nN, gid = wgid / nig, fm = gid * WGM, gsz = (nM - fm) < WGM ? (nM - fm) : WGM;
        u.pm = fm + ((wgid % nig) % gsz); u.pn = (wgid % nig) / gsz; u.xa = 0; u.xb = 0; return true;
    }
    __device__ __forceinline__ void aoff(const Unit& u, const int (&R)[2], const int (&C)[2], unsigned (&o)[2][2]) const {
#pragma unroll
        for (int h = 0; h < 2; ++h)
#pragma unroll
            for (int i = 0; i < 2; ++i) o[h][i] = (unsigned)((u.pm * BM + h * HALF + R[i]) * K + C[i]) * 2u;
    }
};

struct MoeOrder {
    const LAS int* tstart; const LAS int* cnt; const int* rowtok;
    int T, G, c, K;
    __device__ __forceinline__ bool next(int i, Unit& u) const {
        const int L = i * G + c; if (L >= T * 4) return false;
        const int rt = L >> 2, j = L & 3;
        int e = 0;
#pragma unroll
        for (int k = 1; k < NEXP; ++k) e += (rt >= tstart[k]) ? 1 : 0;
        u.pm = rt; u.pn = __builtin_amdgcn_readfirstlane(e * 4 + j);
        u.xa = __builtin_amdgcn_readfirstlane((rt - tstart[e]) * 256); u.xb = __builtin_amdgcn_readfirstlane(cnt[e]); return true;
    }
    __device__ __forceinline__ void aoff(const Unit& u, const int (&R)[2], const int (&C)[2], unsigned (&o)[2][2]) const {
        if (rowtok) {
            const int* rt = rowtok + (size_t)(u.pn >> 2) * ECAP;
#pragma unroll
            for (int h = 0; h < 2; ++h)
#pragma unroll
                for (int i = 0; i < 2; ++i) { const int pos = u.xa + h * HALF + R[i]; int tok = 0; if (pos < u.xb) tok = rt[pos]; o[h][i] = (unsigned)(tok * K + C[i]) * 2u; }
        } else {
#pragma unroll
            for (int h = 0; h < 2; ++h)
#pragma unroll
                for (int i = 0; i < 2; ++i) o[h][i] = (unsigned)((u.pm * BM + h * HALF + R[i]) * K + C[i]) * 2u;
        }
    }
};

template <class Epi, class Sched>
__device__ __forceinline__ void gemm_phase(LAS unsigned char* lds, const Gemm g, const Sched& S, const Epi& E) {
    const int tid = threadIdx.x, wid = __builtin_amdgcn_readfirstlane(tid >> 6), lane = tid & 63, wr = wid >> 2, wc = wid & 3, fr = lane & 15, fq = lane >> 4;
    const int K = g.K, nt = K / BK;
    int Rr[2], Cc[2]; unsigned voffB[2];
#pragma unroll
    for (int i = 0; i < 2; ++i) { int R, C; stage_rc(tid * 16 + i * 8192, R, C); const int Rb = (R & ~31) + perm32(R & 31); Rr[i] = R; Cc[i] = C; voffB[i] = (unsigned)(Rb * K + C) * 2u; }
    const size_t kstep = (size_t)(BK * 2);
    const size_t hstep = (size_t)HALF * K * 2;
    const size_t tstep = 2 * hstep;
    const unsigned ldsw = (unsigned)wid * 1024u;
    const int aoff = lds_byte(wr * 64 + fr, fq * 8), boff = lds_byte(wc * 32 + fr, fq * 8);
#define PG8_SA(b, h) (((b) * 2 + (h)) * HTB)
#define PG8_SB(b, h) ((4 + (b) * 2 + (h)) * HTB)
#define PG8_STAGE(bufoff, gbase, voff) do { _Pragma("unroll") for (int _i = 0; _i < 2; ++_i) \
        __builtin_amdgcn_global_load_lds((const unsigned*)((const char*)(gbase) + (voff)[_i]), (LAS unsigned*)(lds + (bufoff) + ldsw + _i * 8192), 16, 0, 0); } while (0)
#define PG8_LDA(dst, b, h) do { _Pragma("unroll") for (int m = 0; m < 4; ++m) _Pragma("unroll") for (int k = 0; k < 2; ++k) dst[m][k] = *(const LAS bf16x8*)(lds + PG8_SA(b, h) + aoff + m * 2048 + k * 1024); } while (0)
#define PG8_LDB(dst, b, h) do { _Pragma("unroll") for (int n = 0; n < 2; ++n) _Pragma("unroll") for (int k = 0; k < 2; ++k) dst[n][k] = *(const LAS bf16x8*)(lds + PG8_SB(b, h) + boff + n * 2048 + k * 1024); } while (0)
#define PG8_MMA(ai, bj, At, Bt) do { __builtin_amdgcn_s_setprio(1); _Pragma("unroll") for (int m = 0; m < 4; ++m) _Pragma("unroll") for (int n = 0; n < 2; ++n) _Pragma("unroll") for (int k = 0; k < 2; ++k) \
        acc[ai][bj][m][n] = __builtin_amdgcn_mfma_f32_16x16x32_bf16(Bt[n][k], At[m][k], acc[ai][bj][m][n], 0, 0, 0); __builtin_amdgcn_s_setprio(0); } while (0)
#define PG8_WAIT_V(n) asm volatile("s_waitcnt vmcnt(" #n ")" ::: "memory")
#define PG8_WAIT_L(n) asm volatile("s_waitcnt lgkmcnt(" #n ")" ::: "memory")
#define PG8_BAR __builtin_amdgcn_s_barrier()
#define PG8_SCHED __builtin_amdgcn_sched_barrier(0)
    Unit cur, nxt; int ui = 0;
    if (!S.next(0, cur)) return;
    f32x4 acc[2][2][4][2];
#pragma unroll
    for (int a = 0; a < 2; ++a)
#pragma unroll
        for (int b = 0; b < 2; ++b)
#pragma unroll
            for (int m = 0; m < 4; ++m)
#pragma unroll
                for (int n = 0; n < 2; ++n) acc[a][b][m][n] = (f32x4){0.f, 0.f, 0.f, 0.f};
    bf16x8 At[4][2], B0[2][2], B1[2][2];
    unsigned oc[2][2], on[2][2];
    S.aoff(cur, Rr, Cc, oc);
    const char* const gA = (const char*)g.A;
    const char* cB = (const char*)g.Bt + (size_t)cur.pn * tstep;
    PG8_STAGE(PG8_SB(0, 0), cB, voffB); PG8_STAGE(PG8_SB(0, 1), cB + hstep, voffB); PG8_STAGE(PG8_SA(0, 0), gA, oc[0]); PG8_STAGE(PG8_SA(0, 1), gA, oc[1]);
    if (wr == 1) PG8_BAR;
    PG8_WAIT_V(2); PG8_BAR;
    PG8_STAGE(PG8_SB(1, 0), cB + kstep, voffB); PG8_STAGE(PG8_SA(1, 0), gA + kstep, oc[0]); PG8_STAGE(PG8_SB(1, 1), cB + hstep + kstep, voffB);
    PG8_WAIT_V(6); PG8_BAR;
    for (;;) {
        const bool has_next = S.next(ui + 1, nxt);
        if (has_next) S.aoff(nxt, Rr, Cc, on);
        else {
#pragma unroll
            for (int h = 0; h < 2; ++h)
#pragma unroll
                for (int i = 0; i < 2; ++i) on[h][i] = oc[h][i];
        }
        const char* nB = has_next ? (const char*)g.Bt + (size_t)nxt.pn * tstep : cB;
        for (int t = 0; t < nt; t += 2) {
            const bool last = (t == nt - 2);
            const char* a1 = gA + (size_t)(t + 1) * kstep;
            const char* a2 = last ? gA : gA + (size_t)(t + 2) * kstep; const char* b2 = last ? nB : cB + (size_t)(t + 2) * kstep;
            const char* a3 = a2 + kstep; const char* b3 = b2 + kstep;
            unsigned o2[2][2];
#pragma unroll
            for (int h = 0; h < 2; ++h)
#pragma unroll
                for (int i = 0; i < 2; ++i) o2[h][i] = last ? on[h][i] : oc[h][i];
            PG8_LDB(B0, 0, 0); PG8_LDB(B1, 0, 1); PG8_SCHED; PG8_LDA(At, 0, 0); PG8_STAGE(PG8_SA(1, 1), a1, oc[1]);
            PG8_WAIT_V(8); PG8_WAIT_L(0); PG8_BAR; PG8_MMA(0, 0, At, B0); PG8_MMA(0, 1, At, B1); PG8_BAR; PG8_SCHED;
            PG8_LDA(At, 0, 1); PG8_STAGE(PG8_SB(0, 0), b2, voffB); PG8_STAGE(PG8_SB(0, 1), b2 + hstep, voffB); PG8_STAGE(PG8_SA(0, 0), a2, o2[0]);
            PG8_WAIT_V(8); PG8_WAIT_L(0); PG8_BAR; PG8_MMA(1, 0, At, B0); PG8_MMA(1, 1, At, B1); PG8_BAR; PG8_SCHED;
            PG8_LDB(B0, 1, 0); PG8_LDB(B1, 1, 1); PG8_SCHED; PG8_LDA(At, 1, 0); PG8_STAGE(PG8_SA(0, 1), a2, o2[1]);
            PG8_WAIT_V(8); PG8_WAIT_L(0); PG8_BAR; PG8_MMA(0, 0, At, B0); PG8_MMA(0, 1, At, B1); PG8_BAR; PG8_SCHED;
            PG8_LDA(At, 1, 1); PG8_STAGE(PG8_SB(1, 0), b3, voffB); PG8_STAGE(PG8_SB(1, 1), b3 + hstep, voffB); PG8_STAGE(PG8_SA(1, 0), a3, o2[0]);
            PG8_WAIT_V(8); PG8_WAIT_L(0); PG8_BAR; PG8_MMA(1, 0, At, B0); PG8_MMA(1, 1, At, B1); PG8_BAR; PG8_SCHED;
        }
        if (wr == 0) PG8_BAR;
        E(acc, cur, wr, wc, fr, fq);
        if (!has_next) break;
#pragma unroll
        for (int a = 0; a < 2; ++a)
#pragma unroll
            for (int b = 0; b < 2; ++b)
#pragma unroll
                for (int m = 0; m < 4; ++m)
#pragma unroll
                    for (int n = 0; n < 2; ++n) acc[a][b][m][n] = (f32x4){0.f, 0.f, 0.f, 0.f};
        cur = nxt; cB = nB; ++ui;
#pragma unroll
        for (int h = 0; h < 2; ++h)
#pragma unroll
            for (int i = 0; i < 2; ++i) oc[h][i] = on[h][i];
        if (wr == 1) PG8_BAR;
    }
    PG8_WAIT_V(0);
    PG8_BAR;
#undef PG8_SA
#undef PG8_SB
#undef PG8_STAGE
#undef PG8_LDA
#undef PG8_LDB
#undef PG8_MMA
#undef PG8_WAIT_V
#undef PG8_WAIT_L
#undef PG8_BAR
#undef PG8_SCHED
}

struct EpiProj {
    bf16* O; const float* rs;
    __device__ __forceinline__ void operator()(const f32x4 (&acc)[2][2][4][2], const Unit& u, int wr, int wc, int fr, int fq) const {
        const int row0 = u.pm * BM + wr * 64 + fr, col0 = u.pn * BM + wc * 32 + 8 * fq;
#pragma unroll
        for (int ai = 0; ai < 2; ++ai)
#pragma unroll
            for (int m = 0; m < 4; ++m) { const int row = row0 + ai * HALF + m * 16; const float s = rs[row]; bf16* rowp = O + (size_t)row * NPROJ + col0;
#pragma unroll
                for (int bj = 0; bj < 2; ++bj) { const f32x4 v0 = acc[ai][bj][m][0] * s, v1 = acc[ai][bj][m][1] * s;
                    u32x4 w; w.x = pk2(v0[0], v0[1]); w.y = pk2(v0[2], v0[3]); w.z = pk2(v1[0], v1[1]); w.w = pk2(v1[2], v1[3]);
                    *(u32x4*)(rowp + bj * HALF) = w; } }
    }
};
struct EpiOut {
    const float* x; float* out; bf16* hb;
    __device__ __forceinline__ void operator()(const f32x4 (&acc)[2][2][4][2], const Unit& u, int wr, int wc, int fr, int fq) const {
        const int row0 = u.pm * BM + wr * 64 + fr, col0 = u.pn * BM + wc * 32 + 8 * fq;
#pragma unroll
        for (int ai = 0; ai < 2; ++ai)
#pragma unroll
            for (int m = 0; m < 4; ++m) { const size_t off = (size_t)(row0 + ai * HALF + m * 16) * D + col0;
#pragma unroll
                for (int bj = 0; bj < 2; ++bj) { const f32x4 x0 = *(const f32x4*)(x + off + bj * HALF), x1 = *(const f32x4*)(x + off + bj * HALF + 4);
                    const f32x4 h0 = x0 + acc[ai][bj][m][0], h1 = x1 + acc[ai][bj][m][1];
                    *(f32x4*)(out + off + bj * HALF) = h0; *(f32x4*)(out + off + bj * HALF + 4) = h1;
                    u32x4 w; w.x = pk2(h0[0], h0[1]); w.y = pk2(h0[2], h0[3]); w.z = pk2(h1[0], h1[1]); w.w = pk2(h1[2], h1[3]);
                    *(u32x4*)(hb + off + bj * HALF) = w; }
                if (m & 1) asm volatile("" ::: "memory"); }
    }
};
__device__ __forceinline__ float silu_mul(float g, float u) { return g * __builtin_amdgcn_rcpf(1.0f + __builtin_amdgcn_exp2f(-g * LOG2E)) * u; }
struct EpiSwiglu {
    bf16* hid; const float* rowrs;
    __device__ __forceinline__ void operator()(const f32x4 (&acc)[2][2][4][2], const Unit& u, int wr, int wc, int fr, int fq) const {
        const int e = u.pn >> 2, j = u.pn & 3; const float* rsp = rowrs + (size_t)e * ECAP;
#pragma unroll
        for (int ai = 0; ai < 2; ++ai)
#pragma unroll
            for (int m = 0; m < 4; ++m) { const int rl = ai * HALF + wr * 64 + m * 16 + fr, pos = u.xa + rl; float s = 0.f; if (pos < u.xb) s = rsp[pos];
                const f32x4 g0 = acc[ai][0][m][0] * s, g1 = acc[ai][0][m][1] * s, u0 = acc[ai][1][m][0] * s, u1 = acc[ai][1][m][1] * s;
                u32x4 w; w.x = pk2(silu_mul(g0[0], u0[0]), silu_mul(g0[1], u0[1])); w.y = pk2(silu_mul(g0[2], u0[2]), silu_mul(g0[3], u0[3]));
                w.z = pk2(silu_mul(g1[0], u1[0]), silu_mul(g1[1], u1[1])); w.w = pk2(silu_mul(g1[2], u1[2]), silu_mul(g1[3], u1[3]));
                *(u32x4*)(hid + (size_t)(u.pm * BM + rl) * DEXP + j * 128 + wc * 32 + 8 * fq) = w; }
    }
};
struct EpiDown {
    bf16* y; const float* rowgate;
    __device__ __forceinline__ void operator()(const f32x4 (&acc)[2][2][4][2], const Unit& u, int wr, int wc, int fr, int fq) const {
        const int e = u.pn >> 2, j = u.pn & 3; const float* gp = rowgate + (size_t)e * ECAP;
#pragma unroll
        for (int ai = 0; ai < 2; ++ai)
#pragma unroll
            for (int m = 0; m < 4; ++m) { const int rl = ai * HALF + wr * 64 + m * 16 + fr, pos = u.xa + rl; float s = 0.f; if (pos < u.xb) s = gp[pos];
                bf16* rowp = y + (size_t)(u.pm * BM + rl) * D + j * BM + wc * 32 + 8 * fq;
#pragma unroll
                for (int bj = 0; bj < 2; ++bj) { const f32x4 v0 = acc[ai][bj][m][0] * s, v1 = acc[ai][bj][m][1] * s;
                    u32x4 w; w.x = pk2(v0[0], v0[1]); w.y = pk2(v0[2], v0[3]); w.z = pk2(v1[0], v1[1]); w.w = pk2(v1[2], v1[3]);
                    *(u32x4*)(rowp + bj * HALF) = w; } }
    }
};
}

struct Args {
    const float* x; const float* meta; const float* rel_bias; const float* mix_g; const float* w_in; const float* q_g; const float* k_g; const float* sinks;
    const float* conv_w; const float* ga; const float* gc; const float* w_out; const float* ffn_g; const float* w_gr; const float* b_gr; const float* w_er; const float* b_er;
    const float* w_gate; const float* w_up; const float* w_down;
    float* out; unsigned char* ws;
};

template <bool SCALE>
__device__ __forceinline__ void tr_item(const float* W, int ldw, const float* ks, bf16* WT, int ldt, int k0, int n0, int drow0, LAS float* scr, int lane) {
#pragma unroll 8
    for (int i = 0; i < 32; ++i) { const int kk = 2 * i + (lane >> 5); float v = W[(size_t)(k0 + kk) * ldw + n0 + (lane & 31)]; if (SCALE) v *= ks[k0 + kk]; scr[kk * 33 + (lane & 31)] = v; }
    LDS_WAIT(); asm volatile("" ::: "memory");
    const int c = lane & 7;
#pragma unroll
    for (int j = 0; j < 4; ++j) { const int n = (lane >> 3) + 8 * j; const LAS float* s = scr + (8 * c) * 33 + n;
        u32x4 o; o.x = pk2(s[0 * 33], s[1 * 33]); o.y = pk2(s[2 * 33], s[3 * 33]); o.z = pk2(s[4 * 33], s[5 * 33]); o.w = pk2(s[6 * 33], s[7 * 33]);
        *(u32x4*)(WT + (size_t)(drow0 + n) * ldt + k0 + 8 * c) = o; }
    LDS_WAIT(); asm volatile("" ::: "memory");
}

__device__ __forceinline__ void p0_prologue(const Args& a, LAS unsigned char* lds, int G) {
    const int tid = threadIdx.x, lane = tid & 63, wave = tid >> 6;
    unsigned char* ws = a.ws;
    LAS float* scr = (LAS float*)(lds + wave * 16384);
    const int gw = blockIdx.x * 8 + wave, NGW = G * 8;
    bf16* Win = (bf16*)(ws + WS_WIN); bf16* Wout = (bf16*)(ws + WS_WOUT); bf16* Wgu = (bf16*)(ws + WS_WGU); bf16* Wd = (bf16*)(ws + WS_WD);
    constexpr int I_IN = 16 * 72, I_OUT = 16 * 32, I_GU = 32 * 256, I_D = 32 * 256;
    constexpr int NITEMS = I_IN + I_OUT + 2 * I_GU + I_D;
    for (int it = gw; it < NITEMS; it += NGW) {
        int r = it;
        if (r < I_IN) { const int kb = r / 72, nb = r % 72; tr_item<true>(a.w_in, NPROJ, a.mix_g, Win, D, 64 * kb, 32 * nb, 32 * nb, scr, lane); continue; } r -= I_IN;
        if (r < I_OUT) { const int kb = r / 32, nb = r % 32; const int k0 = 64 * kb; const float* ks = k0 < 512 ? a.ga : a.gc - 512;
            tr_item<true>(a.w_out, D, ks, Wout, D, k0, 32 * nb, 32 * nb, scr, lane); continue; } r -= I_OUT;
        if (r < 2 * I_GU) { const int up = r >= I_GU ? 1 : 0; if (up) r -= I_GU; const int e = r >> 8, q = r & 255, kb = q >> 4, nb = q & 15, n0 = 32 * nb;
            const float* W = (up ? a.w_up : a.w_gate) + (size_t)e * D * DEXP;
            tr_item<true>(W, DEXP, a.ffn_g, Wgu, D, 64 * kb, n0, e * 1024 + (n0 >> 7) * 256 + up * 128 + (n0 & 127), scr, lane); continue; } r -= 2 * I_GU;
        { const int e = r >> 8, q = r & 255, kb = q >> 5, nb = q & 31;
            tr_item<false>(a.w_down + (size_t)e * DEXP * D, D, nullptr, Wd, DEXP, 64 * kb, 32 * nb, e * 1024 + 32 * nb, scr, lane); }
    }
    bf16* Wr = (bf16*)(ws + WS_WR);
    for (int idx = blockIdx.x * 512 + tid; idx < 48 * 1024; idx += G * 512) { const int c = idx >> 10, k = idx & 1023;
        float v = 0.f; if (c < 4) v = a.w_gr[k * 4 + c]; else if (c < 36) v = a.w_er[k * 32 + (c - 4)];
        Wr[idx] = (bf16)(pk2(v * a.ffn_g[k], 0.f) & 0xffffu); }
    bf16* XB = (bf16*)(ws + WS_XB); float* rsx = (float*)(ws + WS_RSX);
    for (int m = gw; m < MROWS; m += NGW) {
        f32x4 v[4];
        if (m < MTOK + NMETA) { const float* src = m < MTOK ? a.x + (size_t)m * D : a.meta + (size_t)(m - MTOK) * D;
#pragma unroll
            for (int j = 0; j < 4; ++j) v[j] = *(const f32x4*)(src + 4 * lane + 256 * j);
        } else {
#pragma unroll
            for (int j = 0; j < 4; ++j) v[j] = (f32x4){0.f, 0.f, 0.f, 0.f};
        }
        float s = 0.f;
#pragma unroll
        for (int j = 0; j < 4; ++j) s += (v[j].x * v[j].x + v[j].y * v[j].y) + (v[j].z * v[j].z + v[j].w * v[j].w);
        s = wave_sum(s);
        if (lane == 0) rsx[m] = (m < MTOK + NMETA) ? rsqrtf(s * (1.f / D) + EPS) : 0.f;
#pragma unroll
        for (int j = 0; j < 4; ++j) { u32x2 w; w.x = pk2(v[j].x, v[j].y); w.y = pk2(v[j].z, v[j].w); *(u32x2*)(XB + (size_t)m * D + 4 * lane + 256 * j) = w; }
    }
}

__device__ __forceinline__ int t5_bucket(int n) {
    if (n < 16) return n;
    const float v = logf((float)n * 0.0625f) * (16.0f / 2.0794415416798357f);
    int l = 16 + (int)v; return l < 31 ? l : 31;
}
__device__ __forceinline__ int crow(int r, int hi) { return (r & 3) + 8 * (r >> 2) + 4 * hi; }

__device__ __forceinline__ void p2_attn_conv(const Args& a, LAS unsigned char* lds, int G) {
    const int tid = threadIdx.x, lane = tid & 63, wave = __builtin_amdgcn_readfirstlane(tid >> 6);
    const bf16* PROJ = (const bf16*)(a.ws + WS_PROJ); bf16* MIXED = (bf16*)(a.ws + WS_XB);
    LAS float* biasT = (LAS float*)(lds + BIAS_OFF); LAS float* ssA = (LAS float*)(lds + SSA_OFF);
    for (int unit = blockIdx.x; unit < NB * 64; unit += G) {
        const int b = unit >> 6, blk = unit & 63;
        __syncthreads();
#pragma unroll 2
        for (int it = 0; it < 8; ++it) {
            const int idx = it * 512 + tid; const int chunk = idx & 7, kvh = (idx >> 3) & 1, wk = idx >> 4;
            const int tpos = blk * 128 - 128 + wk;
            const bool valid = tpos >= -NMETA;
            const int row = tpos >= 0 ? b * SEQ + tpos : MTOK + NMETA + tpos;
            u32x4 kraw = {0u, 0u, 0u, 0u}, vraw = {0u, 0u, 0u, 0u};
            if (valid) { const bf16* p = PROJ + (size_t)row * NPROJ + kvh * 64 + chunk * 8; kraw = *(const u32x4*)(p + COL_K); vraw = *(const u32x4*)(p + COL_V); }
            float kf[8];
#pragma unroll
            for (int j = 0; j < 4; ++j) { kf[2 * j] = bflo(kraw[j]); kf[2 * j + 1] = bfhi(kraw[j]); }
            float ss = 0.f;
#pragma unroll
            for (int j = 0; j < 8; ++j) ss += kf[j] * kf[j];
            ss += __shfl_xor(ss, 1); ss += __shfl_xor(ss, 2); ss += __shfl_xor(ss, 4);
            const float sc = rsqrtf(ss * (1.f / 64.f) + EPS) * 0.125f;
            const f32x4 gk0 = *(const f32x4*)(a.k_g + chunk * 8), gk1 = *(const f32x4*)(a.k_g + chunk * 8 + 4);
            const f32x4 gq0 = *(const f32x4*)(a.q_g + chunk * 8), gq1 = *(const f32x4*)(a.q_g + chunk * 8 + 4);
            u32x4 kw;
            kw.x = pk2(kf[0] * sc * gk0[0] * gq0[0], kf[1] * sc * gk0[1] * gq0[1]); kw.y = pk2(kf[2] * sc * gk0[2] * gq0[2], kf[3] * sc * gk0[3] * gq0[3]);
            kw.z = pk2(kf[4] * sc * gk1[0] * gq1[0], kf[5] * sc * gk1[1] * gq1[1]); kw.w = pk2(kf[6] * sc * gk1[2] * gq1[2], kf[7] * sc * gk1[3] * gq1[3]);
            *(LAS u32x4*)(lds + KN_OFF + kvh * KN_HEAD + wk * 128 + ((chunk ^ (wk & 7)) << 4)) = kw;
            const int slot = (wk & ~12) | ((wk & 4) << 1) | ((wk & 8) >> 1);
            LAS unsigned char* vt = lds + VT_OFF + kvh * VT_HEAD + (chunk * 8) * VT_ROW + slot * 2;
#pragma unroll
            for (int j = 0; j < 8; ++j) *(LAS unsigned short*)(vt + j * VT_ROW) = (unsigned short)(vraw[j >> 1] >> (16 * (j & 1)));
        }
        for (int e2 = tid; e2 < 1024; e2 += 512) { const int h = e2 >> 7, dist = e2 & 127; biasT[e2] = a.rel_bias[t5_bucket(dist) * 8 + h]; }
        __syncthreads();
        {
            const int h = wave, kvh = wave >> 2, r = lane & 31, hi = lane >> 5;
            const LAS unsigned char* KnB = lds + KN_OFF + kvh * KN_HEAD; const LAS unsigned char* VTB = lds + VT_OFF + kvh * VT_HEAD;
            const float sink = a.sinks[h];
            const int wkmin = (blk == 0) ? (128 - NMETA) : 0;
            for (int qi = 0; qi < 4; ++qi) {
                const size_t qrow = (size_t)(b * SEQ + blk * 128 + 32 * qi + r);
                u32x4 qraw[4];
#pragma unroll
                for (int s = 0; s < 4; ++s) qraw[s] = *(const u32x4*)(PROJ + qrow * NPROJ + h * 64 + 16 * s + 8 * hi);
                float ss = 0.f;
#pragma unroll
                for (int s = 0; s < 4; ++s)
#pragma unroll
                    for (int j = 0; j < 4; ++j) { const float lo = bflo(qraw[s][j]), hh = bfhi(qraw[s][j]); ss += lo * lo + hh * hh; }
                ss += __shfl_xor(ss, 32);
                const float qsc = rsqrtf(ss * (1.f / 64.f) + EPS);
                bf16x8 qf[4];
#pragma unroll
                for (int s = 0; s < 4; ++s) { u32x4 w;
#pragma unroll
                    for (int j = 0; j < 4; ++j) w[j] = pk2(bflo(qraw[s][j]) * qsc, bfhi(qraw[s][j]) * qsc);
                    qf[s] = __builtin_bit_cast(bf16x8, w); }
                f32x16 S[5];
#pragma unroll
                for (int k5 = 0; k5 < 5; ++k5) {
                    const int key = 32 * (qi + k5) + r;
                    f32x16 accs;
#pragma unroll
                    for (int i = 0; i < 16; ++i) accs[i] = 0.f;
#pragma unroll
                    for (int s = 0; s < 4; ++s) { const bf16x8 kfr = *(const LAS bf16x8*)(KnB + key * 128 + (((2 * s + hi) ^ (key & 7)) << 4));
                        accs = __builtin_amdgcn_mfma_f32_32x32x16_bf16(kfr, qf[s], accs, 0, 0, 0); }
                    S[k5] = accs;
                }
                float mx = sink;
#pragma unroll
                for (int k5 = 0; k5 < 5; ++k5)
#pragma unroll
                    for (int i = 0; i < 16; ++i) { const int cr = crow(i, hi); const int dist = 128 - 32 * k5 + r - cr; const int wk = 32 * (qi + k5) + cr;
                        const bool ok = (dist >= 0) && (dist < 128) && (wk >= wkmin);
                        float v = S[k5][i] + biasT[h * 128 + (dist & 127)]; v = ok ? v : -1e30f; S[k5][i] = v; mx = fmaxf(mx, v); }
                mx = fmaxf(mx, __shfl_xor(mx, 32));
                float l = 0.f;
#pragma unroll
                for (int k5 = 0; k5 < 5; ++k5)
#pragma unroll
                    for (int i = 0; i < 16; ++i) { const float p = __builtin_amdgcn_exp2f((S[k5][i] - mx) * LOG2E); S[k5][i] = p; l += p; }
                l += __shfl_xor(l, 32);
                l += __builtin_amdgcn_exp2f((sink - mx) * LOG2E);
                f32x16 O0, O1;
#pragma unroll
                for (int i = 0; i < 16; ++i) { O0[i] = 0.f; O1[i] = 0.f; }
#pragma unroll
                for (int k5 = 0; k5 < 5; ++k5)
#pragma unroll
                    for (int s2 = 0; s2 < 2; ++s2) {
                        u32x4 pw;
#pragma unroll
                        for (int j = 0; j < 4; ++j) pw[j] = pk2(S[k5][8 * s2 + 2 * j], S[k5][8 * s2 + 2 * j + 1]);
                        const bf16x8 pf = __builtin_bit_cast(bf16x8, pw);
                        const int sl = (32 * (qi + k5) + 16 * s2 + 8 * hi) * 2;
                        const bf16x8 v0 = *(const LAS bf16x8*)(VTB + r * VT_ROW + sl), v1 = *(const LAS bf16x8*)(VTB + (32 + r) * VT_ROW + sl);
                        O0 = __builtin_amdgcn_mfma_f32_32x32x16_bf16(v0, pf, O0, 0, 0, 0);
                        O1 = __builtin_amdgcn_mfma_f32_32x32x16_bf16(v1, pf, O1, 0, 0, 0);
                    }
                const float inv = 1.0f / l;
                float so = 0.f;
#pragma unroll
                for (int i = 0; i < 16; ++i) { O0[i] *= inv; O1[i] *= inv; so += O0[i] * O0[i] + O1[i] * O1[i]; }
                so += __shfl_xor(so, 32);
                if (hi == 0) ssA[qi * 256 + r * 8 + h] = so;
                __syncthreads();
                float tot = 0.f;
#pragma unroll
                for (int hh = 0; hh < 8; ++hh) tot += ssA[qi * 256 + r * 8 + hh];
                const float rsa = rsqrtf(tot * (1.f / 512.f) + EPS);
                bf16* orow = MIXED + qrow * D + h * 64 + 4 * hi;
#pragma unroll
                for (int g4 = 0; g4 < 4; ++g4) {
                    u32x2 w0; w0.x = pk2(O0[4 * g4] * rsa, O0[4 * g4 + 1] * rsa); w0.y = pk2(O0[4 * g4 + 2] * rsa, O0[4 * g4 + 3] * rsa);
                    u32x2 w1; w1.x = pk2(O1[4 * g4] * rsa, O1[4 * g4 + 1] * rsa); w1.y = pk2(O1[4 * g4 + 2] * rsa, O1[4 * g4 + 3] * rsa);
                    *(u32x2*)(orow + 8 * g4) = w0; *(u32x2*)(orow + 32 + 8 * g4) = w1;
                }
            }
        }
        {
            const int c0 = 8 * lane;
            float cw[3][8];
#pragma unroll
            for (int j = 0; j < 3; ++j) { const f32x4 w0 = *(const f32x4*)(a.conv_w + j * 512 + c0), w1 = *(const f32x4*)(a.conv_w + j * 512 + c0 + 4);
#pragma unroll
                for (int i = 0; i < 4; ++i) { cw[j][i] = w0[i]; cw[j][4 + i] = w1[i]; } }
            float u2[8], u1[8];
#pragma unroll
            for (int i = 0; i < 8; ++i) { u2[i] = 0.f; u1[i] = 0.f; }
            for (int tt = -2; tt < 16; ++tt) {
                const int tpos = blk * 128 + wave * 16 + tt;
                const size_t row = tpos >= 0 ? (size_t)(b * SEQ + tpos) : (size_t)(MTOK + NMETA + tpos);
                const bf16* p = PROJ + row * NPROJ + c0;
                const u32x4 cc = *(const u32x4*)(p + COL_CC), ch = *(const u32x4*)(p + COL_CH);
                float u0[8];
#pragma unroll
                for (int j = 0; j < 4; ++j) { u0[2 * j] = bflo(cc[j]) * bflo(ch[j]); u0[2 * j + 1] = bfhi(cc[j]) * bfhi(ch[j]); }
                if (tt >= 0) {
                    const u32x4 cb = *(const u32x4*)(p + COL_CB);
                    float cv[8]; float ss = 0.f;
#pragma unroll
                    for (int j = 0; j < 4; ++j) {
                        const float y0 = cw[0][2 * j] * u2[2 * j] + cw[1][2 * j] * u1[2 * j] + cw[2][2 * j] * u0[2 * j];
                        const float y1 = cw[0][2 * j + 1] * u2[2 * j + 1] + cw[1][2 * j + 1] * u1[2 * j + 1] + cw[2][2 * j + 1] * u0[2 * j + 1];
                        cv[2 * j] = bflo(cb[j]) * y0; cv[2 * j + 1] = bfhi(cb[j]) * y1; ss += cv[2 * j] * cv[2 * j] + cv[2 * j + 1] * cv[2 * j + 1]; }
                    ss = wave_sum(ss);
                    const float rc = rsqrtf(ss * (1.f / 512.f) + EPS);
                    u32x4 w; w.x = pk2(cv[0] * rc, cv[1] * rc); w.y = pk2(cv[2] * rc, cv[3] * rc); w.z = pk2(cv[4] * rc, cv[5] * rc); w.w = pk2(cv[6] * rc, cv[7] * rc);
                    *(u32x4*)(MIXED + row * D + 512 + c0) = w;
                }
#pragma unroll
                for (int i = 0; i < 8; ++i) { u2[i] = u1[i]; u1[i] = u0[i]; }
            }
        }
    }
}

__device__ __forceinline__ void p4_router(const Args& a, LAS unsigned char* lds, int G) {
    const int tid = threadIdx.x, lane = tid & 63, wave = __builtin_amdgcn_readfirstlane(tid >> 6);
    const bf16* HB = (const bf16*)(a.ws + WS_HB); const bf16* Wr = (const bf16*)(a.ws + WS_WR);
    int* rowtok = (int*)(a.ws + WS_ROWTOK); float* rowrs = (float*)(a.ws + WS_ROWRS); float* rowgate = (float*)(a.ws + WS_ROWGATE); int* tokslot = (int*)(a.ws + WS_TOKSLOT);
    unsigned* gcnt = (unsigned*)(a.ws + WS_CTL) + CW_CNT;
    LAS int* lcnt = (LAS int*)(lds + LDSCTL_OFF + MISC_LCNT); LAS int* lbase = (LAS int*)(lds + LDSCTL_OFF + MISC_LBASE);
    LAS float* lg = (LAS float*)(lds + wave * 4096);
    for (int chunk = blockIdx.x; chunk < MTOK / 128; chunk += G) {
        __syncthreads();
        if (tid < NEXP) lcnt[tid] = 0;
        __syncthreads();
        const int t0 = chunk * 128 + wave * 16, r16 = lane & 15, q4 = lane >> 4;
        f32x4 acc[3];
#pragma unroll
        for (int c = 0; c < 3; ++c) acc[c] = (f32x4){0.f, 0.f, 0.f, 0.f};
        float ss = 0.f;
        const bf16* arow = HB + (size_t)(t0 + r16) * D + 8 * q4;
        const bf16* brow = Wr + (size_t)r16 * D + 8 * q4;
#pragma unroll 4
        for (int ks = 0; ks < 32; ++ks) {
            const u32x4 aw = *(const u32x4*)(arow + ks * 32);
#pragma unroll
            for (int j = 0; j < 4; ++j) { const float lo = bflo(aw[j]), hh = bfhi(aw[j]); ss += lo * lo + hh * hh; }
            const bf16x8 af = __builtin_bit_cast(bf16x8, aw);
#pragma unroll
            for (int c = 0; c < 3; ++c) { const bf16x8 bfr = *(const bf16x8*)(brow + (size_t)c * 16 * D + ks * 32); acc[c] = __builtin_amdgcn_mfma_f32_16x16x32_bf16(af, bfr, acc[c], 0, 0, 0); }
        }
        ss += __shfl_xor(ss, 16); ss += __shfl_xor(ss, 32);
#pragma unroll
        for (int c = 0; c < 3; ++c)
#pragma unroll
            for (int i = 0; i < 4; ++i) lg[(4 * q4 + i) * 49 + 16 * c + r16] = acc[c][i];
        LDS_WAIT(); __builtin_amdgcn_wave_barrier();
        int e1 = 0, e2 = 0, p1 = 0, p2 = 0; float g1 = 0.f, g2 = 0.f, rs = 0.f;
        if (lane < 16) {
            rs = rsqrtf(ss * (1.f / D) + EPS);
            const LAS float* my = lg + lane * 49;
            float gl[4];
#pragma unroll
            for (int c = 0; c < 4; ++c) gl[c] = my[c] * rs + a.b_gr[c];
            int gi = 0; float gm = gl[0];
#pragma unroll
            for (int c = 1; c < 4; ++c) if (gl[c] > gm) { gm = gl[c]; gi = c; }
            float gs = 0.f;
#pragma unroll
            for (int c = 0; c < 4; ++c) gs += __expf(gl[c] - gm);
            const float gp = 1.0f / gs;
            float el[8];
#pragma unroll
            for (int e = 0; e < 8; ++e) el[e] = my[4 + gi * 8 + e] * rs + a.b_er[gi * 8 + e];
            int i1 = 0; float v1 = el[0];
#pragma unroll
            for (int e = 1; e < 8; ++e) if (el[e] > v1) { v1 = el[e]; i1 = e; }
            int i2 = -1; float v2 = -3.0e38f;
#pragma unroll
            for (int e = 0; e < 8; ++e) if (e != i1 && el[e] > v2) { v2 = el[e]; i2 = e; }
            const float ex = __expf(v2 - v1); const float w1 = 1.0f / (1.0f + ex), w2 = ex * w1;
            e1 = gi * 8 + i1; e2 = gi * 8 + i2; g1 = gp * w1; g2 = gp * w2;
            p1 = __hip_atomic_fetch_add(lcnt + e1, 1, __ATOMIC_RELAXED, __HIP_MEMORY_SCOPE_WORKGROUP);
            p2 = __hip_atomic_fetch_add(lcnt + e2, 1, __ATOMIC_RELAXED, __HIP_MEMORY_SCOPE_WORKGROUP);
        }
        __syncthreads();
        if (tid < NEXP) { const int n = lcnt[tid]; int base = 0; if (n > 0) base = (int)__hip_atomic_fetch_add(gcnt + 64 * tid, (unsigned)n, __ATOMIC_RELAXED, __HIP_MEMORY_SCOPE_AGENT); lbase[tid] = base; }
        __syncthreads();
        if (lane < 16) {
            const int tok = t0 + lane;
            const int s1 = e1 * ECAP + lbase[e1] + p1, s2 = e2 * ECAP + lbase[e2] + p2;
            rowtok[s1] = tok; rowrs[s1] = rs; rowgate[s1] = g1;
            rowtok[s2] = tok; rowrs[s2] = rs; rowgate[s2] = g2;
            tokslot[2 * tok] = s1; tokslot[2 * tok + 1] = s2;
        }
    }
}

__device__ __forceinline__ int moe_tables(const Args& a, LAS unsigned char* lds) {
    LAS int* tstart = (LAS int*)(lds + LDSCTL_OFF + MISC_TSTART); LAS int* cnt = (LAS int*)(lds + LDSCTL_OFF + MISC_CNT);
    unsigned* gcnt = (unsigned*)(a.ws + WS_CTL) + CW_CNT;
    __syncthreads();
    if (threadIdx.x == 0) { int s = 0;
        for (int e = 0; e < NEXP; ++e) { const int c = (int)__hip_atomic_load(gcnt + 64 * e, __ATOMIC_RELAXED, __HIP_MEMORY_SCOPE_AGENT); cnt[e] = c; tstart[e] = s; s += (c + 255) >> 8; }
        tstart[NEXP] = s; }
    __syncthreads();
    return tstart[NEXP];
}

__global__ void __launch_bounds__(512, 2) hymba_fwd(Args a) {
    extern __shared__ __attribute__((aligned(16))) unsigned char lds_raw[];
    LAS unsigned char* lds = (LAS unsigned char*)lds_raw;
    const int tid = threadIdx.x, lane = tid & 63, wave = tid >> 6;
    const int G = gridDim.x;
    unsigned char* ws = a.ws;
    for (int u = tid; u < (LDS_BYTES - LDSCTL_OFF) / 4; u += 512) ((LAS unsigned*)(lds + LDSCTL_OFF))[u] = 0u;
    __syncthreads();
    XcdBarrier bar = xcd_barrier_post((unsigned*)(ws + WS_CTL) + CW_BAR, (volatile LAS unsigned*)(lds + LDSCTL_OFF + MISC_BAR));

    p0_prologue(a, lds, G);
    xcd_barrier(bar);
    {
        pg8::Gemm g{(const bf16*)(ws + WS_XB), (const bf16*)(ws + WS_WIN), D};
        pg8::StaticOrder S; S.init(MROWS, NPROJ, D, G, (int)blockIdx.x);
        pg8::EpiProj E{(bf16*)(ws + WS_PROJ), (const float*)(ws + WS_RSX)};
        pg8::gemm_phase(lds, g, S, E);
    }
    xcd_barrier(bar);
    p2_attn_conv(a, lds, G);
    xcd_barrier(bar);
    {
        pg8::Gemm g{(const bf16*)(ws + WS_XB), (const bf16*)(ws + WS_WOUT), D};
        pg8::StaticOrder S; S.init(MTOK, D, D, G, (int)blockIdx.x);
        pg8::EpiOut E{a.x, a.out, (bf16*)(ws + WS_HB)};
        pg8::gemm_phase(lds, g, S, E);
    }
    xcd_barrier(bar);
    p4_router(a, lds, G);
    xcd_barrier(bar);
    {
        const int T = moe_tables(a, lds);
        pg8::Gemm g{(const bf16*)(ws + WS_HB), (const bf16*)(ws + WS_WGU), D};
        pg8::MoeOrder S{(const LAS int*)(lds + LDSCTL_OFF + MISC_TSTART), (const LAS int*)(lds + LDSCTL_OFF + MISC_CNT), (const int*)(ws + WS_ROWTOK), T, G, (int)blockIdx.x, D};
        pg8::EpiSwiglu E{(bf16*)(ws + WS_HID), (const float*)(ws + WS_ROWRS)};
        pg8::gemm_phase(lds, g, S, E);
    }
    xcd_barrier(bar);
    {
        const int T = moe_tables(a, lds);
        pg8::Gemm g{(const bf16*)(ws + WS_HID), (const bf16*)(ws + WS_WD), DEXP};
        pg8::MoeOrder S{(const LAS int*)(lds + LDSCTL_OFF + MISC_TSTART), (const LAS int*)(lds + LDSCTL_OFF + MISC_CNT), nullptr, T, G, (int)blockIdx.x, DEXP};
        pg8::EpiDown E{(bf16*)(ws + WS_YBUF), (const float*)(ws + WS_ROWGATE)};
        pg8::gemm_phase(lds, g, S, E);
    }
    xcd_barrier(bar);
    {
        const LAS int* tstart = (const LAS int*)(lds + LDSCTL_OFF + MISC_TSTART);
        const int* tokslot = (const int*)(ws + WS_TOKSLOT); const bf16* Y = (const bf16*)(ws + WS_YBUF);
        const int gw = blockIdx.x * 8 + wave, NGW = G * 8;
        for (int t = gw; t < MTOK; t += NGW) {
            const int s0 = tokslot[2 * t], s1 = tokslot[2 * t + 1];
            const size_t r0 = (size_t)(tstart[s0 >> 15] * 256 + (s0 & (ECAP - 1))), r1 = (size_t)(tstart[s1 >> 15] * 256 + (s1 & (ECAP - 1)));
#pragma unroll
            for (int j = 0; j < 4; ++j) { const int c = 4 * lane + 256 * j;
                f32x4 o = *(const f32x4*)(a.out + (size_t)t * D + c);
                const u32x2 y0 = *(const u32x2*)(Y + r0 * D + c), y1 = *(const u32x2*)(Y + r1 * D + c);
                o[0] += bflo(y0.x) + bflo(y1.x); o[1] += bfhi(y0.x) + bfhi(y1.x); o[2] += bflo(y0.y) + bflo(y1.y); o[3] += bfhi(y0.y) + bfhi(y1.y);
                *(f32x4*)(a.out + (size_t)t * D + c) = o; }
        }
    }
}

extern "C" void kernel_launch(void* const* d_in, const int* in_sizes, int n_in, void* d_out, int out_size, void* d_ws, size_t ws_size, hipStream_t stream) {
    static int grid = 0;
    if (grid == 0) {
        if (n_in != 20 || in_sizes[0] != MTOK * D || out_size != MTOK * D || ws_size < WS_END) {
            fprintf(stderr, "kernel_launch: unexpected shapes (n_in %d, in0 %d, out %d, ws %zu; need ws >= %zu); nothing launched\n", n_in, n_in > 0 ? in_sizes[0] : -1, out_size, ws_size, (size_t)WS_END);
            grid = -1; return; }
        int dev = 0, cus = 0;
        if (hipGetDevice(&dev) != hipSuccess || hipDeviceGetAttribute(&cus, hipDeviceAttributeMultiprocessorCount, dev) != hipSuccess) { grid = -1; return; }
        if (hipFuncSetAttribute((const void*)hymba_fwd, hipFuncAttributeMaxDynamicSharedMemorySize, LDS_BYTES) != hipSuccess) { fprintf(stderr, "kernel_launch: hipFuncSetAttribute failed\n"); grid = -1; return; }
        int per_cu = 0;
        if (hipOccupancyMaxActiveBlocksPerMultiprocessor(&per_cu, (const void*)hymba_fwd, 512, LDS_BYTES) != hipSuccess || per_cu < 1) { fprintf(stderr, "kernel_launch: occupancy query reports %d\n", per_cu); }
        (void)hipGetLastError();
        grid = cus;
    }
    if (grid < 0) return;
    if (hipMemsetAsync((char*)d_ws + WS_CTL, 0, CTL_BYTES, stream) != hipSuccess) return;
    Args a{};
    a.x = (const float*)d_in[0]; a.meta = (const float*)d_in[1]; a.rel_bias = (const float*)d_in[2]; a.mix_g = (const float*)d_in[3]; a.w_in = (const float*)d_in[4];
    a.q_g = (const float*)d_in[5]; a.k_g = (const float*)d_in[6]; a.sinks = (const float*)d_in[7]; a.conv_w = (const float*)d_in[8]; a.ga = (const float*)d_in[9];
    a.gc = (const float*)d_in[10]; a.w_out = (const float*)d_in[11]; a.ffn_g = (const float*)d_in[12]; a.w_gr = (const float*)d_in[13]; a.b_gr = (const float*)d_in[14];
    a.w_er = (const float*)d_in[15]; a.b_er = (const float*)d_in[16]; a.w_gate = (const float*)d_in[17]; a.w_up = (const float*)d_in[18]; a.w_down = (const float*)d_in[19];
    a.out = (float*)d_out; a.ws = (unsigned char*)d_ws;
    hipLaunchKernelGGL(hymba_fwd, dim3(grid), dim3(512), LDS_BYTES, stream, a);
}
```

```cpp
#include <hip/hip_runtime.h>
#include <cstdio>
#include <cstdint>
#ifndef AMP_PHASE
#define AMP_PHASE -1
#endif
#define AMP_N 4

#define LAS __attribute__((address_space(3)))
#define GAS __attribute__((address_space(1)))
typedef unsigned short bf16;
typedef short bf16x8 __attribute__((ext_vector_type(8)));
typedef short bf16x16_t __attribute__((ext_vector_type(16)));
typedef float f32x4 __attribute__((ext_vector_type(4)));
typedef float f32x16 __attribute__((ext_vector_type(16)));
typedef unsigned u32x4 __attribute__((ext_vector_type(4)));
typedef unsigned u32x2 __attribute__((ext_vector_type(2)));
typedef float f32x2_t __attribute__((ext_vector_type(2)));
typedef __bf16 bf16x2_t __attribute__((ext_vector_type(2)));

constexpr int NB = 4, SEQ = 8192, D = 1024, NMETA = 16;
constexpr int MTOK = NB * SEQ;
constexpr int MROWS = MTOK + 256;
constexpr int NPROJ = 2304;
constexpr int COL_K = 512, COL_V = 640, COL_CB = 768, COL_U = 1280;
constexpr int NEXP = 32, DEXP = 512, ECAP = 32768;
constexpr int MAXTILES = 288;
constexpr float EPS = 1e-6f;
constexpr float LOG2E = 1.4426950408889634f;

constexpr size_t MiB = 1u << 20;
constexpr size_t WS_CTL = 0, CTL_BYTES = 128 * 1024;
constexpr size_t WS_ROWTOK = 1 * MiB;
constexpr size_t WS_ROWRS = 5 * MiB;
constexpr size_t WS_ROWGATE = 9 * MiB;
constexpr size_t WS_TOKSLOT = 13 * MiB;
constexpr size_t WS_RSX = 13 * MiB + 512 * 1024;
constexpr size_t WS_WR = 14 * MiB;
constexpr size_t WS_WIN = 15 * MiB;
constexpr size_t WS_WOUT = 20 * MiB;
constexpr size_t WS_WGU = 22 * MiB;
constexpr size_t WS_HB8 = 54 * MiB;
constexpr size_t WS_WD = 86 * MiB;
constexpr size_t WS_XB = 118 * MiB;
constexpr size_t WS_PROJ = 184 * MiB;
constexpr size_t WS_HB = WS_PROJ;
constexpr size_t WS_HID = WS_PROJ + 64 * MiB;
constexpr size_t WS_YBUF = 332 * MiB;
constexpr size_t WS_MIXED = WS_YBUF;
constexpr size_t WS_END = 476 * MiB;
static_assert(WS_XB + (size_t)MROWS * D * 2 <= WS_PROJ && WS_PROJ + (size_t)MROWS * NPROJ * 2 <= WS_YBUF && WS_HID + (size_t)MAXTILES * 256 * DEXP * 2 <= WS_YBUF &&
              WS_YBUF + (size_t)MAXTILES * 256 * D * 2 <= WS_END, "d_ws map");
constexpr int CW_BAR = 4096;
constexpr int CW_CNT = 16384;
constexpr int CW_Q = 20480;

constexpr int LDS_BYTES = 147456;
constexpr int RING_BYTES = 131072;
constexpr int LDSCTL_OFF = 146432;
constexpr int SCAL_OFF = 142336;
constexpr int MISC_BAR = 0, MISC_TSTART = 64, MISC_CNT = 256, MISC_LCNT = 384, MISC_LBASE = 512;
constexpr int KN_OFF = 0, KN_HEAD = 32768;
constexpr int VT_OFF = 65536, VT_ROW = 528, VT_HEAD = 64 * VT_ROW;
constexpr int BIAS_OFF = VT_OFF + 2 * VT_HEAD;
constexpr int SSA_OFF = BIAS_OFF + 6144;
static_assert(SSA_OFF + 4096 <= LDSCTL_OFF, "P2 LDS map");

__device__ __forceinline__ unsigned pk2(float lo, float hi) { f32x2_t v = {lo, hi}; bf16x2_t b = __builtin_convertvector(v, bf16x2_t); return __builtin_bit_cast(unsigned, b); }
typedef int v8i_t __attribute__((ext_vector_type(8)));
typedef int v4i_t __attribute__((ext_vector_type(4)));
constexpr float Y8_SCALE = 16.0f, Y8_INV = 1.0f / 16.0f;
constexpr float W8_SCALE = 32.0f, W8_INV = 1.0f / 32.0f;
__device__ __forceinline__ unsigned pk4_fp8(float a, float b, float c, float d) { int w = 0; w = __builtin_amdgcn_cvt_pk_fp8_f32(a, b, w, false); w = __builtin_amdgcn_cvt_pk_fp8_f32(c, d, w, true); return (unsigned)w; }
__device__ __forceinline__ float bflo(unsigned w) { return __uint_as_float(w << 16); }
__device__ __forceinline__ float bfhi(unsigned w) { return __uint_as_float(w & 0xffff0000u); }
__device__ __forceinline__ float wave_sum(float v) {
#pragma unroll
    for (int o = 1; o < 64; o <<= 1) v += __shfl_xor(v, o);
    return v;
}
#define LDS_WAIT() asm volatile("s_waitcnt lgkmcnt(0)" ::: "memory")
#define VM_WAIT() asm volatile("s_waitcnt vmcnt(0)" ::: "memory")

#define XB_TMO      128
#define XB_XCNT(j)  (256  + 64 * (j))
#define XB_XSUB(j)  (1280 + 64 * (j))
#define XB_XGEN(j)  (2304 + 64 * (j))
#define XB_TOP      3328
#define XB_TOPGEN   3392
#define XCD_BAR_WORDS 3456
#define XB_SPIN_CAP (1u << 18)
__device__ __forceinline__ unsigned xb_ld(unsigned* p)              { return __hip_atomic_load(p, __ATOMIC_RELAXED, __HIP_MEMORY_SCOPE_AGENT); }
__device__ __forceinline__ unsigned xb_add(unsigned* p, unsigned v) { return __hip_atomic_fetch_add(p, v, __ATOMIC_RELAXED, __HIP_MEMORY_SCOPE_AGENT); }
__device__ __forceinline__ unsigned xb_xcc_id() { return (unsigned)__builtin_amdgcn_s_getreg((3 << 11) | 20) & 0xFu; }
#define XB_SPIN(cond, bar) do { unsigned _sp = 0; while (cond) { __builtin_amdgcn_s_sleep(1); \
    if ((++_sp & 255u) == 0u) { if (xb_ld(&(bar)[XB_TMO])) break; if (_sp > XB_SPIN_CAP) { atomicAdd(&(bar)[XB_TMO], 1u); break; } } } } while (0)
struct XcdBarrier { unsigned* bar; unsigned x; volatile LAS unsigned* st; };
__device__ __forceinline__ XcdBarrier xcd_barrier_post(unsigned* bar, volatile LAS unsigned* st) {
    XcdBarrier b; b.bar = bar; b.x = xb_xcc_id(); b.st = st;
    if (threadIdx.x == 0) (void)xb_add(&bar[XB_XCNT(b.x)], 1u);
    return b;
}
__device__ __forceinline__ void xcd_barrier_complete(unsigned* bar, unsigned x, unsigned& nloc, unsigned& nx) {
    const unsigned G = gridDim.x * gridDim.y * gridDim.z;
    unsigned sum, cnt, mine, sp = 0u;
    for (;;) {
        sum = 0u; cnt = 0u; mine = 0u;
#pragma unroll
        for (unsigned j = 0; j < 16; ++j) { const unsigned c = xb_ld(&bar[XB_XCNT(j)]); sum += c; cnt += (c > 0u) ? 1u : 0u; mine = (j == x) ? c : mine; }
        if (sum == G) break;
        __builtin_amdgcn_s_sleep(1);
        if ((++sp & 255u) == 0u) { if (xb_ld(&bar[XB_TMO])) break; if (sp > XB_SPIN_CAP) { atomicAdd(&bar[XB_TMO], 1u); break; } }
    }
    nloc = mine > 0u ? mine : 1u; nx = cnt > 0u ? cnt : 1u;
}
__device__ __forceinline__ void xcd_barrier(const XcdBarrier& b) {
    asm volatile("s_waitcnt vmcnt(0)" ::: "memory");
    __syncthreads();
    if (threadIdx.x == 0) {
        unsigned* bar = b.bar;
        __builtin_amdgcn_s_waitcnt(0);
        unsigned nloc = b.st[0], nx = b.st[1];
        if (nloc == 0u) { xcd_barrier_complete(bar, b.x, nloc, nx); b.st[0] = nloc; b.st[1] = nx; }
        const unsigned old = xb_add(&bar[XB_XSUB(b.x)], 1u);
        const unsigned gen = old / nloc;
        if (old + 1u == (gen + 1u) * nloc) {
            __builtin_amdgcn_fence(__ATOMIC_RELEASE, "agent");
            asm volatile("s_waitcnt vmcnt(0)" ::: "memory");
            const unsigned og = xb_add(&bar[XB_TOP], 1u);
            const unsigned tg = og / nx;
            if (og + 1u == (tg + 1u) * nx) xb_add(&bar[XB_TOPGEN], 1u);
            else XB_SPIN(xb_ld(&bar[XB_TOPGEN]) == tg, bar);
            __builtin_amdgcn_fence(__ATOMIC_ACQUIRE, "agent");
            xb_add(&bar[XB_XGEN(b.x)], 1u);
            asm volatile("s_waitcnt vmcnt(0)" ::: "memory");
        } else {
            XB_SPIN(xb_ld(&bar[XB_XGEN(b.x)]) == gen, bar);
            __builtin_amdgcn_fence(__ATOMIC_ACQUIRE, "agent");
            asm volatile("s_waitcnt vmcnt(0)" ::: "memory");
        }
    }
    __syncthreads();
}

__device__ __forceinline__ int moe_cpos(int c, int G) { if (G != 256) return c; const int x = c & 7, q = c >> 3; return ((x * 8 + (q & 7)) << 2) + (q >> 3); }
namespace pg8 {
constexpr int BM = 256, BK = 64, HALF = 128, HTB = HALF * BK * 2, STAGE_BYTES = 8 * HTB, NXCD = 8, WGM = 8;
__host__ __device__ __forceinline__ int lds_byte(int r, int c) { const int st = (r >> 4) * 2 + (c >> 5), rr = r & 15, cc = c & 31, ob = rr * 64 + cc * 2; return st * 1024 + (ob ^ (((ob >> 9) & 1) << 5)); }
__host__ __device__ __forceinline__ void stage_rc(int b, int& R, int& C) { const int st = b / 1024, sb = b % 1024, swz = sb ^ (((sb >> 9) & 1) << 5); R = (st >> 1) * 16 + swz / 64; C = (st & 1) * 32 + (swz % 64) / 2; }
__host__ __device__ __forceinline__ int perm32(int rho) { const int n = rho >> 4, i = rho & 15; return 8 * (i >> 2) + 4 * n + (i & 3); }

struct Unit { int pm, pn, xa, xb; };
struct Gemm { const bf16* A; const bf16* Bt; int K; };

struct StaticOrder {
    int nM, nN, nwg, G, c, K, i0, i1;
    __device__ void init(int M, int N, int K_, int G_, int c_) { nM = M / BM; nN = N / BM; nwg = nM * nN; G = G_; c = c_; K = K_; i0 = 0; i1 = 1 << 24; }
    __device__ __forceinline__ bool next(int i, Unit& u) const {
        i += i0; if (i >= i1) return false;
        const long L = (long)i * G + c; if (L >= nwg) return false;
        int wgid = (int)L; { const int q = nwg / NXCD, r = nwg % NXCD, xcd = wgid % NXCD, off = wgid / NXCD; wgid = (xcd < r ? xcd * (q + 1) : r * (q + 1) + (xcd - r) * q) + off; }
        const int nig = WGM * nN, gid = wgid / nig, fm = gid * WGM, gsz = (nM - fm) < WGM ? (nM - fm) : WGM;
        u.pm = fm + ((wgid % nig) % gsz); u.pn = (wgid % nig) / gsz; u.xa = 0; u.xb = 0; return true;
    }
    __device__ __forceinline__ void aoff(const Unit& u, const int (&R)[2], const int (&C)[2], unsigned (&o)[2][2]) const {
#pragma unroll
        for (int h = 0; h < 2; ++h)
#pragma unroll
            for (int i = 0; i < 2; ++i) o[h][i] = (unsigned)((u.pm * BM + h * HALF + R[i]) * K + C[i]) * 2u;
    }
};

struct MoeOrder {
    const LAS int* tstart; const LAS int* cnt; const int* rowtok;
    int T, G, c, K, i0, i1;
    __device__ __forceinline__ bool next(int i, Unit& u) const {
        i += i0; if (i >= i1) return false;
        const int L = i * G + c; if (L >= T * 4) return false;
        const int rt = L >> 2, j = L & 3;
        int e = 0;
#pragma unroll
        for (int k = 1; k < NEXP; ++k) e += (rt >= tstart[k]) ? 1 : 0;
        u.pm = rt; u.pn = __builtin_amdgcn_readfirstlane(e * 4 + j);
        u.xa = __builtin_amdgcn_readfirstlane((rt - tstart[e]) * 256); u.xb = __builtin_amdgcn_readfirstlane(cnt[e]); return true;
    }
    __device__ __forceinline__ void aoff(const Unit& u, const int (&R)[2], const int (&C)[2], unsigned (&o)[2][2]) const {
        if (rowtok) {
            const int* rt = rowtok + (size_t)(u.pn >> 2) * ECAP;
#pragma unroll
            for (int h = 0; h < 2; ++h)
#pragma unroll
                for (int i = 0; i < 2; ++i) { const int pos = u.xa + h * HALF + R[i]; int tok = 0; if (pos < u.xb) tok = rt[pos]; o[h][i] = (unsigned)(tok * K + C[i]) * 2u; }
        } else {
#pragma unroll
            for (int h = 0; h < 2; ++h)
#pragma unroll
                for (int i = 0; i < 2; ++i) o[h][i] = (unsigned)((u.pm * BM + h * HALF + R[i]) * K + C[i]) * 2u;
        }
    }
};

template <bool FP8, class Epi, class Sched>
__device__ __forceinline__ void gemm_phase(LAS unsigned char* lds, const Gemm g, const Sched& S, const Epi& E) {
    const int tid = threadIdx.x, wid = __builtin_amdgcn_readfirstlane(tid >> 6), lane = tid & 63, wr = wid >> 2, wc = wid & 3, fr = lane & 15, fq = lane >> 4;
    const int K = g.K, nt = K / BK;
    int Rr[2], Cc[2]; unsigned voffB[2];
#pragma unroll
    for (int i = 0; i < 2; ++i) { int R, C; stage_rc(tid * 16 + i * 8192, R, C); const int Rb = (R & ~31) + perm32(R & 31); Rr[i] = R; Cc[i] = C; voffB[i] = (unsigned)(Rb * K + C) * 2u; }
    const size_t kstep = (size_t)(BK * 2);
    const size_t hstep = (size_t)HALF * K * 2;
    const size_t tstep = 2 * hstep;
    const unsigned ldsw = (unsigned)wid * 1024u;
    const int aoff = lds_byte(wr * 64 + fr, fq * 8), boff = lds_byte(wc * 32 + fr, fq * 8);
#define PG8_SA(b, h) (((b) * 2 + (h)) * HTB)
#define PG8_SB(b, h) ((4 + (b) * 2 + (h)) * HTB)
#define PG8_STAGE(bufoff, gbase, voff) do { _Pragma("unroll") for (int _i = 0; _i < 2; ++_i) \
        __builtin_amdgcn_global_load_lds((const unsigned*)((const char*)(gbase) + (voff)[_i]), (LAS unsigned*)(lds + (bufoff) + ldsw + _i * 8192), 16, 0, 0); } while (0)
#define PG8_LDA_BF(dst, b, h) do { _Pragma("unroll") for (int m = 0; m < 4; ++m) _Pragma("unroll") for (int k = 0; k < 2; ++k) dst[m][k] = *(const LAS bf16x8*)(lds + PG8_SA(b, h) + aoff + m * 2048 + k * 1024); } while (0)
#define PG8_LDB_BF(dst, b, h) do { _Pragma("unroll") for (int n = 0; n < 2; ++n) _Pragma("unroll") for (int k = 0; k < 2; ++k) dst[n][k] = *(const LAS bf16x8*)(lds + PG8_SB(b, h) + boff + n * 2048 + k * 1024); } while (0)
#define PG8_MMA_BF(ai, bj, At, Bt) do { __builtin_amdgcn_s_setprio(1); _Pragma("unroll") for (int m = 0; m < 4; ++m) _Pragma("unroll") for (int n = 0; n < 2; ++n) _Pragma("unroll") for (int k = 0; k < 2; ++k) \
        acc[ai][bj][m][n] = __builtin_amdgcn_mfma_f32_16x16x32_bf16(Bt[n][k], At[m][k], acc[ai][bj][m][n], 0, 0, 0); __builtin_amdgcn_s_setprio(0); } while (0)
#define PG8_LDA_F8(dst, b, h) do { _Pragma("unroll") for (int m = 0; m < 4; ++m) { const v4i_t lo_ = *(const LAS v4i_t*)(lds + PG8_SA(b, h) + aoff + m * 2048), hi_ = *(const LAS v4i_t*)(lds + PG8_SA(b, h) + aoff + m * 2048 + 1024); \
        dst##8[m] = __builtin_shufflevector(lo_, hi_, 0, 1, 2, 3, 4, 5, 6, 7); } } while (0)
#define PG8_LDB_F8(dst, b, h) do { _Pragma("unroll") for (int n = 0; n < 2; ++n) { const v4i_t lo_ = *(const LAS v4i_t*)(lds + PG8_SB(b, h) + boff + n * 2048), hi_ = *(const LAS v4i_t*)(lds + PG8_SB(b, h) + boff + n * 2048 + 1024); \
        dst##8[n] = __builtin_shufflevector(lo_, hi_, 0, 1, 2, 3, 4, 5, 6, 7); } } while (0)
#define PG8_MMA_F8(ai, bj, At, Bt) do { __builtin_amdgcn_s_setprio(1); _Pragma("unroll") for (int m = 0; m < 4; ++m) _Pragma("unroll") for (int n = 0; n < 2; ++n) \
        asm volatile("v_mfma_scale_f32_16x16x128_f8f6f4 %0, %1, %2, %0, %3, %3 op_sel_hi:[0,0,0]" : "+v"(acc[ai][bj][m][n]) : "v"(Bt##8[n]), "v"(At##8[m]), "v"(f8scale)); \
        __builtin_amdgcn_s_setprio(0); } while (0)
#define PG8_F8_DRAIN asm volatile("s_nop 15\n\ts_nop 15" ::: "memory")
#define PG8_LDA(dst, b, h) do { if constexpr (FP8) PG8_LDA_F8(dst, b, h); else PG8_LDA_BF(dst, b, h); } while (0)
#define PG8_LDB(dst, b, h) do { if constexpr (FP8) PG8_LDB_F8(dst, b, h); else PG8_LDB_BF(dst, b, h); } while (0)
#define PG8_MMA(ai, bj, At, Bt) do { if constexpr (FP8) PG8_MMA_F8(ai, bj, At, Bt); else PG8_MMA_BF(ai, bj, At, Bt); } while (0)
#define PG8_WAIT_V(n) asm volatile("s_waitcnt vmcnt(" #n ")" ::: "memory")
#define PG8_WAIT_L(n) asm volatile("s_waitcnt lgkmcnt(" #n ")" ::: "memory")
#define PG8_BAR __builtin_amdgcn_s_barrier()
#define PG8_SCHED __builtin_amdgcn_sched_barrier(0)
    int f8scale = 0x7F7F7F7F; asm volatile("" : "+v"(f8scale));
    Unit cur, nxt; int ui = 0;
    if (!S.next(0, cur)) return;
    f32x4 acc[2][2][4][2];
#pragma unroll
    for (int a = 0; a < 2; ++a)
#pragma unroll
        for (int b = 0; b < 2; ++b)
#pragma unroll
            for (int m = 0; m < 4; ++m)
#pragma unroll
                for (int n = 0; n < 2; ++n) acc[a][b][m][n] = (f32x4){0.f, 0.f, 0.f, 0.f};
    bf16x8 At[4][2], B0[2][2], B1[2][2];
    v8i_t At8[4], B08[2], B18[2];
    unsigned oc[2][2], on[2][2];
    S.aoff(cur, Rr, Cc, oc);
    int sl_cur = 0;
    E.pre(cur, lds + SCAL_OFF, wid, lane);
    const char* const gA = (const char*)g.A;
    const char* cB = (const char*)g.Bt + (size_t)cur.pn * tstep;
    PG8_STAGE(PG8_SB(0, 0), cB, voffB); PG8_STAGE(PG8_SB(0, 1), cB + hstep, voffB); PG8_STAGE(PG8_SA(0, 0), gA, oc[0]); PG8_STAGE(PG8_SA(0, 1), gA, oc[1]);
    if (wr == 1) PG8_BAR;
    PG8_WAIT_V(2); PG8_BAR;
    PG8_STAGE(PG8_SB(1, 0), cB + kstep, voffB); PG8_STAGE(PG8_SA(1, 0), gA + kstep, oc[0]); PG8_STAGE(PG8_SB(1, 1), cB + hstep + kstep, voffB);
    PG8_WAIT_V(6); PG8_BAR;
    for (;;) {
        const bool has_next = S.next(ui + 1, nxt);
        const int sl_nxt = sl_cur == 2 ? 0 : sl_cur + 1;
        if (has_next) { S.aoff(nxt, Rr, Cc, on); E.pre(nxt, lds + SCAL_OFF + sl_nxt * 1024, wid, lane); }
        else {
#pragma unroll
            for (int h = 0; h < 2; ++h)
#pragma unroll
                for (int i = 0; i < 2; ++i) on[h][i] = oc[h][i];
        }
        const char* nB = has_next ? (const char*)g.Bt + (size_t)nxt.pn * tstep : cB;
#pragma unroll 1
        for (int t = 0; t < nt; t += 2) {
            const bool last = (t == nt - 2);
            const char* a1 = gA + (size_t)(t + 1) * kstep;
            const char* a2 = last ? gA : gA + (size_t)(t + 2) * kstep; const char* b2 = last ? nB : cB + (size_t)(t + 2) * kstep;
            const char* a3 = a2 + kstep; const char* b3 = b2 + kstep;
            unsigned o2[2][2];
#pragma unroll
            for (int h = 0; h < 2; ++h)
#pragma unroll
                for (int i = 0; i < 2; ++i) o2[h][i] = last ? on[h][i] : oc[h][i];
            PG8_LDB(B0, 0, 0); PG8_LDB(B1, 0, 1); PG8_SCHED; PG8_LDA(At, 0, 0); PG8_STAGE(PG8_SA(1, 1), a1, oc[1]);
            PG8_WAIT_V(8); PG8_WAIT_L(0); PG8_BAR; PG8_MMA(0, 0, At, B0); PG8_MMA(0, 1, At, B1); PG8_BAR; PG8_SCHED;
            PG8_LDA(At, 0, 1); PG8_STAGE(PG8_SB(0, 0), b2, voffB); PG8_STAGE(PG8_SB(0, 1), b2 + hstep, voffB); PG8_STAGE(PG8_SA(0, 0), a2, o2[0]);
            PG8_WAIT_V(8); PG8_WAIT_L(0); PG8_BAR; PG8_MMA(1, 0, At, B0); PG8_MMA(1, 1, At, B1); PG8_BAR; PG8_SCHED;
            PG8_LDB(B0, 1, 0); PG8_LDB(B1, 1, 1); PG8_SCHED; PG8_LDA(At, 1, 0); PG8_STAGE(PG8_SA(0, 1), a2, o2[1]);
            PG8_WAIT_V(8); PG8_WAIT_L(0); PG8_BAR; PG8_MMA(0, 0, At, B0); PG8_MMA(0, 1, At, B1); PG8_BAR; PG8_SCHED;
            PG8_LDA(At, 1, 1); PG8_STAGE(PG8_SB(1, 0), b3, voffB); PG8_STAGE(PG8_SB(1, 1), b3 + hstep, voffB); PG8_STAGE(PG8_SA(1, 0), a3, o2[0]);
            PG8_WAIT_V(8); PG8_WAIT_L(0); PG8_BAR; PG8_MMA(1, 0, At, B0); PG8_MMA(1, 1, At, B1); PG8_BAR; PG8_SCHED;
        }
        if constexpr (FP8) PG8_F8_DRAIN;
        if (wr == 0) PG8_BAR;
        E(acc, cur, wr, wc, fr, fq, (const LAS float*)(lds + SCAL_OFF + sl_cur * 1024));
        if (!has_next) break;
#pragma unroll
        for (int a = 0; a < 2; ++a)
#pragma unroll
            for (int b = 0; b < 2; ++b)
#pragma unroll
                for (int m = 0; m < 4; ++m)
#pragma unroll
                    for (int n = 0; n < 2; ++n) acc[a][b][m][n] = (f32x4){0.f, 0.f, 0.f, 0.f};
        cur = nxt; cB = nB; ++ui; sl_cur = sl_nxt;
#pragma unroll
        for (int h = 0; h < 2; ++h)
#pragma unroll
            for (int i = 0; i < 2; ++i) oc[h][i] = on[h][i];
        if (wr == 1) PG8_BAR;
    }
    PG8_WAIT_V(0);
    PG8_BAR;
#undef PG8_SA
#undef PG8_SB
#undef PG8_STAGE
#undef PG8_LDA
#undef PG8_LDA_BF
#undef PG8_LDA_F8
#undef PG8_LDB_BF
#undef PG8_LDB_F8
#undef PG8_MMA_BF
#undef PG8_MMA_F8
#undef PG8_F8_DRAIN
#undef PG8_LDB
#undef PG8_MMA
#undef PG8_WAIT_V
#undef PG8_WAIT_L
#undef PG8_BAR
#undef PG8_SCHED
}

struct EpiProj {
    bf16* O; const float* rs;
    __device__ __forceinline__ void pre(const Unit& u, LAS unsigned char* slot, int wid, int lane) const {
        if (wid < 4) __builtin_amdgcn_global_load_lds((const unsigned*)(rs + u.pm * BM + wid * 64 + lane), (LAS unsigned*)(slot + wid * 256), 4, 0, 0);
    }
    __device__ __forceinline__ void operator()(const f32x4 (&acc)[2][2][4][2], const Unit& u, int wr, int wc, int fr, int fq, const LAS float* scal) const {
        const int row0 = u.pm * BM + wr * 64 + fr, col0 = u.pn * BM + wc * 32 + 8 * fq;
        float sc[2][4];
#pragma unroll
        for (int ai = 0; ai < 2; ++ai)
#pragma unroll
            for (int m = 0; m < 4; ++m) sc[ai][m] = scal[ai * HALF + wr * 64 + m * 16 + fr];
        if (u.pn >= 5) {
#pragma unroll
            for (int ai = 0; ai < 2; ++ai)
#pragma unroll
                for (int m = 0; m < 4; ++m) { const int row = row0 + ai * HALF + m * 16; const float s2 = sc[ai][m] * sc[ai][m];
                    const f32x4 v0 = acc[ai][0][m][0] * acc[ai][1][m][0] * s2, v1 = acc[ai][0][m][1] * acc[ai][1][m][1] * s2;
                    u32x4 w; w.x = pk2(v0[0], v0[1]); w.y = pk2(v0[2], v0[3]); w.z = pk2(v1[0], v1[1]); w.w = pk2(v1[2], v1[3]);
                    *(u32x4*)(O + (size_t)row * NPROJ + COL_U + (u.pn - 5) * 128 + wc * 32 + 8 * fq) = w; }
            return;
        }
#pragma unroll
        for (int ai = 0; ai < 2; ++ai)
#pragma unroll
            for (int m = 0; m < 4; ++m) { const int row = row0 + ai * HALF + m * 16; const float s = sc[ai][m]; bf16* rowp = O + (size_t)row * NPROJ + col0;
#pragma unroll
                for (int bj = 0; bj < 2; ++bj) { const f32x4 v0 = acc[ai][bj][m][0] * s, v1 = acc[ai][bj][m][1] * s;
                    u32x4 w; w.x = pk2(v0[0], v0[1]); w.y = pk2(v0[2], v0[3]); w.z = pk2(v1[0], v1[1]); w.w = pk2(v1[2], v1[3]);
                    *(u32x4*)(rowp + bj * HALF) = w; } }
    }
};
struct EpiOut {
    const bf16* xb; bf16* hb; unsigned char* hb8;
    __device__ __forceinline__ void pre(const Unit&, LAS unsigned char*, int, int) const {}
    __device__ __forceinline__ void operator()(const f32x4 (&acc)[2][2][4][2], const Unit& u, int wr, int wc, int fr, int fq, const LAS float*) const {
        const int row0 = u.pm * BM + wr * 64 + fr, col0 = u.pn * BM + wc * 32 + 8 * fq;
        u32x4 xr[2][4][2];
#pragma unroll
        for (int ai = 0; ai < 2; ++ai)
#pragma unroll
            for (int m = 0; m < 4; ++m) { const size_t off = (size_t)(row0 + ai * HALF + m * 16) * D + col0;
#pragma unroll
                for (int bj = 0; bj < 2; ++bj) xr[ai][m][bj] = *(const u32x4*)(xb + off + bj * HALF); }
#pragma unroll
        for (int ai = 0; ai < 2; ++ai)
#pragma unroll
            for (int m = 0; m < 4; ++m) { const size_t off = (size_t)(row0 + ai * HALF + m * 16) * D + col0;
#pragma unroll
                for (int bj = 0; bj < 2; ++bj) { const u32x4 xw = xr[ai][m][bj]; const f32x4 a0 = acc[ai][bj][m][0], a1 = acc[ai][bj][m][1];
                    const float h0 = bflo(xw.x) + a0[0], h1 = bfhi(xw.x) + a0[1], h2 = bflo(xw.y) + a0[2], h3 = bfhi(xw.y) + a0[3];
                    const float h4 = bflo(xw.z) + a1[0], h5 = bfhi(xw.z) + a1[1], h6 = bflo(xw.w) + a1[2], h7 = bfhi(xw.w) + a1[3];
                    u32x4 w; w.x = pk2(h0, h1); w.y = pk2(h2, h3); w.z = pk2(h4, h5); w.w = pk2(h6, h7);
                    *(u32x4*)(hb + off + bj * HALF) = w;
                    u32x2 w8; w8.x = pk4_fp8(h0, h1, h2, h3); w8.y = pk4_fp8(h4, h5, h6, h7);
                    *(u32x2*)(hb8 + off + bj * HALF) = w8; } }
    }
};
__device__ __forceinline__ float silu_mul(float g, float u) { return g * __builtin_amdgcn_rcpf(1.0f + __builtin_amdgcn_exp2f(-g * LOG2E)) * u; }
struct EpiSwiglu {
    unsigned char* hid; const float* rowrs;
    __device__ __forceinline__ void pre(const Unit& u, LAS unsigned char* slot, int wid, int lane) const {
        if (wid < 4) __builtin_amdgcn_global_load_lds((const unsigned*)(rowrs + (size_t)(u.pn >> 2) * ECAP + u.xa + wid * 64 + lane), (LAS unsigned*)(slot + wid * 256), 4, 0, 0);
    }
    __device__ __forceinline__ void operator()(const f32x4 (&acc)[2][2][4][2], const Unit& u, int wr, int wc, int fr, int fq, const LAS float* scal) const {
        const int j = u.pn & 3;
        float sc[2][4];
#pragma unroll
        for (int ai = 0; ai < 2; ++ai)
#pragma unroll
            for (int m = 0; m < 4; ++m) { const int rl = ai * HALF + wr * 64 + m * 16 + fr; sc[ai][m] = (u.xa + rl < u.xb) ? scal[rl] * W8_INV : 0.f; }
#pragma unroll
        for (int ai = 0; ai < 2; ++ai)
#pragma unroll
            for (int m = 0; m < 4; ++m) { const int rl = ai * HALF + wr * 64 + m * 16 + fr; const float s = sc[ai][m];
                const f32x4 g0 = acc[ai][0][m][0] * s, g1 = acc[ai][0][m][1] * s, u0 = acc[ai][1][m][0] * s, u1 = acc[ai][1][m][1] * s;
                u32x2 w; w.x = pk4_fp8(silu_mul(g0[0], u0[0]), silu_mul(g0[1], u0[1]), silu_mul(g0[2], u0[2]), silu_mul(g0[3], u0[3]));
                w.y = pk4_fp8(silu_mul(g1[0], u1[0]), silu_mul(g1[1], u1[1]), silu_mul(g1[2], u1[2]), silu_mul(g1[3], u1[3]));
                *(u32x2*)(hid + (size_t)(u.pm * BM + rl) * DEXP + j * 128 + wc * 32 + 8 * fq) = w; }
    }
};
struct EpiDown {
    unsigned char* y; const float* rowgate;
    __device__ __forceinline__ void pre(const Unit& u, LAS unsigned char* slot, int wid, int lane) const {
        if (wid < 4) __builtin_amdgcn_global_load_lds((const unsigned*)(rowgate + (size_t)(u.pn >> 2) * ECAP + u.xa + wid * 64 + lane), (LAS unsigned*)(slot + wid * 256), 4, 0, 0);
    }
    __device__ __forceinline__ void operator()(const f32x4 (&acc)[2][2][4][2], const Unit& u, int wr, int wc, int fr, int fq, const LAS float* scal) const {
        const int j = u.pn & 3;
        float sc[2][4];
#pragma unroll
        for (int ai = 0; ai < 2; ++ai)
#pragma unroll
            for (int m = 0; m < 4; ++m) { const int rl = ai * HALF + wr * 64 + m * 16 + fr; sc[ai][m] = (u.xa + rl < u.xb) ? scal[rl] * (W8_INV * Y8_SCALE) : 0.f; }
#pragma unroll
        for (int ai = 0; ai < 2; ++ai)
#pragma unroll
            for (int m = 0; m < 4; ++m) { const int rl = ai * HALF + wr * 64 + m * 16 + fr; const float s = sc[ai][m];
                unsigned char* rowp = y + (size_t)(u.pm * BM + rl) * D + j * BM + wc * 32 + 8 * fq;
#pragma unroll
                for (int bj = 0; bj < 2; ++bj) { const f32x4 v0 = acc[ai][bj][m][0] * s, v1 = acc[ai][bj][m][1] * s;
                    u32x2 w; w.x = pk4_fp8(v0[0], v0[1], v0[2], v0[3]); w.y = pk4_fp8(v1[0], v1[1], v1[2], v1[3]);
                    *(u32x2*)(rowp + bj * HALF) = w; } }
    }
};
}

struct Args {
    const float* x; const float* meta; const float* rel_bias; const float* mix_g; const float* w_in; const float* q_g; const float* k_g; const float* sinks;
    const float* conv_w; const float* ga; const float* gc; const float* w_out; const float* ffn_g; const float* w_gr; const float* b_gr; const float* w_er; const float* b_er;
    const float* w_gate; const float* w_up; const float* w_down;
    float* out; unsigned char* ws;
};

struct TrRegs { f32x4 v[2][8]; float sk[8]; };
template <bool SCALE>
__device__ __forceinline__ void tr_load(TrRegs& t, const float* W, int ldw, const float* ks, int k0, int n0, int lane) {
    const int q = lane & 7, kg = lane >> 3;
    const float* src = W + (size_t)(k0 + 8 * kg) * ldw + n0 + 4 * q;
#pragma unroll
    for (int hh = 0; hh < 2; ++hh)
#pragma unroll
        for (int i = 0; i < 8; ++i) t.v[hh][i] = __builtin_nontemporal_load((const f32x4*)(src + (size_t)i * ldw + 32 * hh));
    if (SCALE) { const f32x4 s0 = *(const f32x4*)(ks + k0 + 8 * kg), s1 = *(const f32x4*)(ks + k0 + 8 * kg + 4);
#pragma unroll
        for (int i = 0; i < 4; ++i) { t.sk[i] = s0[i]; t.sk[4 + i] = s1[i]; } }
    else {
#pragma unroll
        for (int i = 0; i < 8; ++i) t.sk[i] = 1.f; }
}
__device__ __forceinline__ void tr_store(const TrRegs& t, bf16* WT, int ldt, int k0, int drow0, int lane) {
    const int q = lane & 7, kg = lane >> 3;
#pragma unroll
    for (int hh = 0; hh < 2; ++hh)
#pragma unroll
        for (int ni = 0; ni < 4; ++ni) {
            u32x4 o; o.x = pk2(t.v[hh][0][ni] * t.sk[0], t.v[hh][1][ni] * t.sk[1]); o.y = pk2(t.v[hh][2][ni] * t.sk[2], t.v[hh][3][ni] * t.sk[3]);
            o.z = pk2(t.v[hh][4][ni] * t.sk[4], t.v[hh][5][ni] * t.sk[5]); o.w = pk2(t.v[hh][6][ni] * t.sk[6], t.v[hh][7][ni] * t.sk[7]);
            *(u32x4*)(WT + (size_t)(drow0 + 32 * hh + 4 * q + ni) * ldt + k0 + 8 * kg) = o; }
}
template <bool SCALE>
__device__ __forceinline__ void tr_item(const float* W, int ldw, const float* ks, bf16* WT, int ldt, int k0, int n0, int drow0, int lane) {
    TrRegs t; tr_load<SCALE>(t, W, ldw, ks, k0, n0, lane); tr_store(t, WT, ldt, k0, drow0, lane);
}

struct TrItem { f32x4 v[16]; float sk[16]; };
__device__ __forceinline__ void conv_item_load(TrItem& t, const Args& a, int pool, int it, int lane) {
    const int q = lane & 7, kg = lane >> 3;
    const float* W; int ldw, k0, n0;
    if (pool == 0) { int r = it; const int up = r >= 4096 ? 1 : 0; if (up) r -= 4096; const int e = r >> 7, qq = r & 127; k0 = 128 * (qq >> 4); n0 = 32 * (qq & 15); W = (up ? a.w_up : a.w_gate) + (size_t)e * D * DEXP; ldw = DEXP; }
    else { const int e = it >> 7, qq = it & 127; k0 = 128 * (qq >> 5); n0 = 32 * (qq & 31); W = a.w_down + (size_t)e * DEXP * D; ldw = D; }
    const float* src = W + (size_t)(k0 + 16 * kg) * ldw + n0 + 4 * q;
#pragma unroll
    for (int i = 0; i < 16; ++i) t.v[i] = *(const f32x4*)(src + (size_t)i * ldw);
    if (pool == 0) {
#pragma unroll
        for (int i4 = 0; i4 < 4; ++i4) { const f32x4 sv = *(const f32x4*)(a.ffn_g + k0 + 16 * kg + 4 * i4);
#pragma unroll
            for (int i = 0; i < 4; ++i) t.sk[4 * i4 + i] = sv[i] * W8_SCALE; }
    } else {
#pragma unroll
        for (int i = 0; i < 16; ++i) t.sk[i] = W8_SCALE;
    }
}
__device__ __forceinline__ void conv_item_store(const TrItem& t, const Args& a, int pool, int it, int lane) {
    const int q = lane & 7, kg = lane >> 3;
    unsigned char* WT; int ldt, k0, drow0;
    if (pool == 0) { int r = it; const int up = r >= 4096 ? 1 : 0; if (up) r -= 4096; const int e = r >> 7, qq = r & 127, n0 = 32 * (qq & 15); k0 = 128 * (qq >> 4);
        WT = a.ws + WS_WGU; ldt = D; drow0 = e * 1024 + (n0 >> 7) * 256 + up * 128 + (n0 & 127); }
    else { const int e = it >> 7, qq = it & 127; k0 = 128 * (qq >> 5); WT = a.ws + WS_WD; ldt = DEXP; drow0 = e * 1024 + 32 * (qq & 31); }
#pragma unroll
    for (int ni = 0; ni < 4; ++ni) {
        u32x4 o;
        o.x = pk4_fp8(t.v[0][ni] * t.sk[0], t.v[1][ni] * t.sk[1], t.v[2][ni] * t.sk[2], t.v[3][ni] * t.sk[3]);
        o.y = pk4_fp8(t.v[4][ni] * t.sk[4], t.v[5][ni] * t.sk[5], t.v[6][ni] * t.sk[6], t.v[7][ni] * t.sk[7]);
        o.z = pk4_fp8(t.v[8][ni] * t.sk[8], t.v[9][ni] * t.sk[9], t.v[10][ni] * t.sk[10], t.v[11][ni] * t.sk[11]);
        o.w = pk4_fp8(t.v[12][ni] * t.sk[12], t.v[13][ni] * t.sk[13], t.v[14][ni] * t.sk[14], t.v[15][ni] * t.sk[15]);
        *(u32x4*)(WT + (size_t)(drow0 + 4 * q + ni) * ldt + k0 + 16 * kg) = o; }
}
__device__ __forceinline__ void conv_pool(const Args& a, int pool, int rank, int nranks, int total) {
    const int lane = threadIdx.x & 63, wave = threadIdx.x >> 6;
    const int gwv = rank * 8 + wave, NW = nranks * 8;
    if (gwv >= total) return;
    const int n = (total - gwv + NW - 1) / NW;
    const int last = gwv + (n - 1) * NW;
    TrItem r0, r1;
    conv_item_load(r0, a, pool, min(gwv, last), lane); conv_item_load(r1, a, pool, min(gwv + NW, last), lane);
    for (int j = 0; j < n; j += 2) {
        const int b0 = gwv + j * NW;
        conv_item_store(r0, a, pool, min(b0, last), lane);      conv_item_load(r0, a, pool, min(b0 + 2 * NW, last), lane);
        conv_item_store(r1, a, pool, min(b0 + NW, last), lane); conv_item_load(r1, a, pool, min(b0 + 3 * NW, last), lane);
    }
}
__device__ __forceinline__ int conv_slot(int nunits, int G, int c) {
    const int rem = nunits % G;
    if (rem == 0) return -2;
    if (c < rem) return -1;
    const int nmine = nunits / G;
    return (c - rem) % (nmine + 1);
}
__device__ __forceinline__ void conv_mine(const Args& a, int pool, int nunits, int G, int c, int total) {
    const int rem = nunits % G;
    if (rem == 0) conv_pool(a, pool, c, G, total); else conv_pool(a, pool, c - rem, G - rem, total);
}
__device__ __forceinline__ void conv_dyn(const Args& a, int pool, int lo, int hi, LAS unsigned char* lds, unsigned* q) {
    const int lane = threadIdx.x & 63, wave = threadIdx.x >> 6;
    volatile LAS int* tk = (volatile LAS int*)(lds + LDSCTL_OFF + 640);
    for (;;) {
        __syncthreads();
        if (threadIdx.x == 0) *tk = (int)__hip_atomic_fetch_add(q, 1u, __ATOMIC_RELAXED, __HIP_MEMORY_SCOPE_AGENT);
        __syncthreads();
        const int base = lo + (*tk) * 8;
        if (base >= hi) break;
        const int it = base + wave;
        if (it < hi) { TrItem r; conv_item_load(r, a, pool, it, lane); conv_item_store(r, a, pool, it, lane); }
    }
}

__device__ __forceinline__ void p0_prologue(const Args& a, LAS unsigned char* lds, int G) {
    const int tid = threadIdx.x, lane = tid & 63, wave = tid >> 6;
    unsigned char* ws = a.ws;
    const int gw = blockIdx.x * 8 + wave, NGW = G * 8;
    bf16* Win = (bf16*)(ws + WS_WIN); bf16* Wout = (bf16*)(ws + WS_WOUT);
    constexpr int I_IN = 16 * 36, I_OUT = 16 * 16;
    constexpr int NITEMS = I_IN + I_OUT;
    for (int it = gw; it < NITEMS; it += NGW) {
        int r = it;
        if (r < I_IN) { const int kb = r / 36, nb = r % 36, n0 = 64 * nb;
            int drow = n0;
            if (n0 >= 1792) { const int c = n0 - 1792; drow = 1280 + (c >> 7) * 256 + 128 + (c & 127); } else if (n0 >= 1280) { const int c = n0 - 1280; drow = 1280 + (c >> 7) * 256 + (c & 127); }
            tr_item<true>(a.w_in, NPROJ, a.mix_g, Win, D, 64 * kb, n0, drow, lane); continue; } r -= I_IN;
        { const int kb = r >> 4, nb = r & 15; const int k0 = 64 * kb; const float* ks = k0 < 512 ? a.ga : a.gc - 512;
            tr_item<true>(a.w_out, D, ks, Wout, D, k0, 64 * nb, 64 * nb, lane); }
    }
    bf16* Wr = (bf16*)(ws + WS_WR);
    for (int idx = blockIdx.x * 512 + tid; idx < 48 * 1024; idx += G * 512) { const int c = idx >> 10, k = idx & 1023;
        float v = 0.f; if (c < 4) v = a.w_gr[k * 4 + c]; else if (c < 36) v = a.w_er[k * 32 + (c - 4)];
        Wr[idx] = (bf16)(pk2(v * a.ffn_g[k], 0.f) & 0xffffu); }
    bf16* XB = (bf16*)(ws + WS_XB); float* rsx = (float*)(ws + WS_RSX);
    for (int m0 = 2 * gw; m0 < MROWS; m0 += 2 * NGW) {
        f32x4 v[2][4];
#pragma unroll
        for (int rr = 0; rr < 2; ++rr) { const int m = m0 + rr;
            if (m < MTOK + NMETA) { const float* src = m < MTOK ? a.x + (size_t)m * D : a.meta + (size_t)(m - MTOK) * D;
#pragma unroll
                for (int j = 0; j < 4; ++j) v[rr][j] = __builtin_nontemporal_load((const f32x4*)(src + 4 * lane + 256 * j));
            } else {
#pragma unroll
                for (int j = 0; j < 4; ++j) v[rr][j] = (f32x4){0.f, 0.f, 0.f, 0.f};
            } }
#pragma unroll
        for (int rr = 0; rr < 2; ++rr) { const int m = m0 + rr;
            float s = 0.f;
#pragma unroll
            for (int j = 0; j < 4; ++j) s += (v[rr][j].x * v[rr][j].x + v[rr][j].y * v[rr][j].y) + (v[rr][j].z * v[rr][j].z + v[rr][j].w * v[rr][j].w);
            s = wave_sum(s);
            if (lane == 0) rsx[m] = (m < MTOK + NMETA) ? rsqrtf(s * (1.f / D) + EPS) : 0.f;
#pragma unroll
            for (int j = 0; j < 4; ++j) { u32x2 w; w.x = pk2(v[rr][j].x, v[rr][j].y); w.y = pk2(v[rr][j].z, v[rr][j].w); *(u32x2*)(XB + (size_t)m * D + 4 * lane + 256 * j) = w; } }
    }
}

__device__ __forceinline__ int t5_bucket(int n) {
    if (n < 16) return n;
    const float v = logf((float)n * 0.0625f) * (16.0f / 2.0794415416798357f);
    int l = 16 + (int)v; return l < 31 ? l : 31;
}
__device__ __forceinline__ int crow(int r, int hi) { return (r & 3) + 8 * (r >> 2) + 4 * hi; }

__device__ __forceinline__ void p2_attn_conv(const Args& a, LAS unsigned char* lds, int G) {
    const int tid = threadIdx.x, lane = tid & 63, wave = __builtin_amdgcn_readfirstlane(tid >> 6);
    const bf16* PROJ = (const bf16*)(a.ws + WS_PROJ); bf16* MIXED = (bf16*)(a.ws + WS_MIXED);
    LAS float* biasT = (LAS float*)(lds + BIAS_OFF); LAS float* ssA = (LAS float*)(lds + SSA_OFF);
    for (int unit = blockIdx.x; unit < NB * 64; unit += G) {
        const int b = unit >> 6, blk = unit & 63;
        __syncthreads();
        u32x4 qraw[4];
        {
            const size_t qrow0 = (size_t)(b * SEQ + blk * 128 + (lane & 31));
#pragma unroll
            for (int s4 = 0; s4 < 4; ++s4) qraw[s4] = __builtin_nontemporal_load((const u32x4*)(PROJ + qrow0 * NPROJ + wave * 64 + 16 * s4 + 8 * (lane >> 5)));
        }
        const f32x4 gk0 = *(const f32x4*)(a.k_g + (tid & 7) * 8), gk1 = *(const f32x4*)(a.k_g + (tid & 7) * 8 + 4);
        const f32x4 gq0 = *(const f32x4*)(a.q_g + (tid & 7) * 8), gq1 = *(const f32x4*)(a.q_g + (tid & 7) * 8 + 4);
        const f32x4 gs0 = gk0 * gq0 * (0.125f * LOG2E), gs1 = gk1 * gq1 * (0.125f * LOG2E);
#pragma unroll 1
        for (int pass = 0; pass < 2; ++pass) {
            u32x4 kraw[4], vraw[4];
#pragma unroll
            for (int i4 = 0; i4 < 4; ++i4) {
                const int idx = (pass * 4 + i4) * 512 + tid; const int chunk = idx & 7, kvh = (idx >> 3) & 1, wk = idx >> 4;
                const int tpos = blk * 128 - 128 + wk;
                const int row = tpos >= 0 ? b * SEQ + tpos : MTOK + NMETA + tpos;
                kraw[i4] = (u32x4){0u, 0u, 0u, 0u}; vraw[i4] = (u32x4){0u, 0u, 0u, 0u};
                if (tpos >= -NMETA) { const bf16* p = PROJ + (size_t)row * NPROJ + kvh * 64 + chunk * 8; kraw[i4] = *(const u32x4*)(p + COL_K); vraw[i4] = *(const u32x4*)(p + COL_V); }
            }
#pragma unroll
            for (int i4 = 0; i4 < 4; ++i4) {
                const int idx = (pass * 4 + i4) * 512 + tid; const int chunk = idx & 7, kvh = (idx >> 3) & 1, wk = idx >> 4;
                float kf[8];
#pragma unroll
                for (int j = 0; j < 4; ++j) { kf[2 * j] = bflo(kraw[i4][j]); kf[2 * j + 1] = bfhi(kraw[i4][j]); }
                float ss = 0.f;
#pragma unroll
                for (int j = 0; j < 8; ++j) ss += kf[j] * kf[j];
                ss += __shfl_xor(ss, 1); ss += __shfl_xor(ss, 2); ss += __shfl_xor(ss, 4);
                const float sc = rsqrtf(ss * (1.f / 64.f) + EPS);
                u32x4 kw;
                kw.x = pk2(kf[0] * sc * gs0[0], kf[1] * sc * gs0[1]); kw.y = pk2(kf[2] * sc * gs0[2], kf[3] * sc * gs0[3]);
                kw.z = pk2(kf[4] * sc * gs1[0], kf[5] * sc * gs1[1]); kw.w = pk2(kf[6] * sc * gs1[2], kf[7] * sc * gs1[3]);
                *(LAS u32x4*)(lds + KN_OFF + kvh * KN_HEAD + wk * 128 + ((chunk ^ (wk & 7)) << 4)) = kw;
                const int slot = ((wk & ~12) | ((wk & 4) << 1) | ((wk & 8) >> 1)) ^ (chunk << 3);
                LAS unsigned char* vt = lds + VT_OFF + kvh * VT_HEAD + (chunk * 8) * VT_ROW + slot * 2;
#pragma unroll
                for (int j = 0; j < 8; ++j) *(LAS unsigned short*)(vt + j * VT_ROW) = (unsigned short)(vraw[i4][j >> 1] >> (16 * (j & 1)));
            }
        }
        for (int e2 = tid; e2 < 8 * 192; e2 += 512) { const int h = e2 / 192, dist = e2 % 192 - 31; biasT[e2] = (dist >= 0 && dist < 128) ? a.rel_bias[t5_bucket(dist) * 8 + h] * LOG2E : -1e30f; }
        __syncthreads();
        {
            const int h = wave, kvh = wave >> 2, r = lane & 31, hi = lane >> 5;
            const LAS unsigned char* KnB = lds + KN_OFF + kvh * KN_HEAD; const LAS unsigned char* VTB = lds + VT_OFF + kvh * VT_HEAD;
            const float sink = a.sinks[h] * LOG2E;
            const int wkmin = (blk == 0) ? (128 - NMETA) : 0;
            for (int qi = 0; qi < 4; ++qi) {
                const size_t qrow = (size_t)(b * SEQ + blk * 128 + 32 * qi + r);
                float ss = 0.f;
#pragma unroll
                for (int s = 0; s < 4; ++s)
#pragma unroll
                    for (int j = 0; j < 4; ++j) { const float lo = bflo(qraw[s][j]), hh = bfhi(qraw[s][j]); ss += lo * lo + hh * hh; }
                ss += __shfl_xor(ss, 32);
                const float qsc = rsqrtf(ss * (1.f / 64.f) + EPS);
                bf16x8 qf[4];
#pragma unroll
                for (int s = 0; s < 4; ++s) { u32x4 w;
#pragma unroll
                    for (int j = 0; j < 4; ++j) w[j] = pk2(bflo(qraw[s][j]) * qsc, bfhi(qraw[s][j]) * qsc);
                    qf[s] = __builtin_bit_cast(bf16x8, w); }
                if (qi < 3) {
#pragma unroll
                    for (int s = 0; s < 4; ++s) qraw[s] = __builtin_nontemporal_load((const u32x4*)(PROJ + (qrow + 32) * NPROJ + h * 64 + 16 * s + 8 * hi));
                }
                f32x16 S[5];
#pragma unroll
                for (int k5 = 0; k5 < 5; ++k5) {
                    const int key = 32 * (qi + k5) + r;
                    f32x16 accs;
#pragma unroll
                    for (int i = 0; i < 16; ++i) accs[i] = 0.f;
#pragma unroll
                    for (int s = 0; s < 4; ++s) { const bf16x8 kfr = *(const LAS bf16x8*)(KnB + key * 128 + (((2 * s + hi) ^ (key & 7)) << 4));
                        accs = __builtin_amdgcn_mfma_f32_32x32x16_bf16(kfr, qf[s], accs, 0, 0, 0); }
                    S[k5] = accs;
                }
                const LAS float* bt = biasT + h * 192 + 31 + 128 + r - 4 * hi;
#pragma unroll
                for (int k5 = 0; k5 < 5; ++k5)
#pragma unroll
                    for (int i = 0; i < 16; ++i) S[k5][i] += bt[-32 * k5 - ((i & 3) + 8 * (i >> 2))];
                if (blk == 0) {
#pragma unroll
                    for (int k5 = 0; k5 < 5; ++k5)
#pragma unroll
                        for (int i = 0; i < 16; ++i) if (32 * (qi + k5) + crow(i, hi) < wkmin) S[k5][i] = -1e30f;
                }
                float mx = sink;
#pragma unroll
                for (int k5 = 0; k5 < 5; ++k5)
#pragma unroll
                    for (int i = 0; i < 16; ++i) mx = fmaxf(mx, S[k5][i]);
                mx = fmaxf(mx, __shfl_xor(mx, 32));
                float l = 0.f;
#pragma unroll
                for (int k5 = 0; k5 < 5; ++k5)
#pragma unroll
                    for (int i = 0; i < 16; ++i) { const float p = __builtin_amdgcn_exp2f(S[k5][i] - mx); S[k5][i] = p; l += p; }
                l += __shfl_xor(l, 32);
                l += __builtin_amdgcn_exp2f(sink - mx);
                f32x16 O0, O1;
#pragma unroll
                for (int i = 0; i < 16; ++i) { O0[i] = 0.f; O1[i] = 0.f; }
#pragma unroll
                for (int k5 = 0; k5 < 5; ++k5)
#pragma unroll
                    for (int s2 = 0; s2 < 2; ++s2) {
                        u32x4 pw;
#pragma unroll
                        for (int j = 0; j < 4; ++j) pw[j] = pk2(S[k5][8 * s2 + 2 * j], S[k5][8 * s2 + 2 * j + 1]);
                        const bf16x8 pf = __builtin_bit_cast(bf16x8, pw);
                        const int sl = 32 * (qi + k5) + 16 * s2 + 8 * hi;
                        const bf16x8 v0 = *(const LAS bf16x8*)(VTB + r * VT_ROW + ((sl ^ ((r >> 3) << 3)) << 1)), v1 = *(const LAS bf16x8*)(VTB + (32 + r) * VT_ROW + ((sl ^ ((4 + (r >> 3)) << 3)) << 1));
                        O0 = __builtin_amdgcn_mfma_f32_32x32x16_bf16(v0, pf, O0, 0, 0, 0);
                        O1 = __builtin_amdgcn_mfma_f32_32x32x16_bf16(v1, pf, O1, 0, 0, 0);
                    }
                const float inv = 1.0f / l;
                float so = 0.f;
#pragma unroll
                for (int i = 0; i < 16; ++i) { O0[i] *= inv; O1[i] *= inv; so += O0[i] * O0[i] + O1[i] * O1[i]; }
                so += __shfl_xor(so, 32);
                if (hi == 0) ssA[qi * 256 + r * 8 + h] = so;
                __syncthreads();
                float tot = 0.f;
#pragma unroll
                for (int hh = 0; hh < 8; ++hh) tot += ssA[qi * 256 + r * 8 + hh];
                const float rsa = rsqrtf(tot * (1.f / 512.f) + EPS);
                bf16* orow = MIXED + qrow * D + h * 64 + 4 * hi;
#pragma unroll
                for (int g4 = 0; g4 < 4; ++g4) {
                    u32x2 w0; w0.x = pk2(O0[4 * g4] * rsa, O0[4 * g4 + 1] * rsa); w0.y = pk2(O0[4 * g4 + 2] * rsa, O0[4 * g4 + 3] * rsa);
                    u32x2 w1; w1.x = pk2(O1[4 * g4] * rsa, O1[4 * g4 + 1] * rsa); w1.y = pk2(O1[4 * g4 + 2] * rsa, O1[4 * g4 + 3] * rsa);
                    *(u32x2*)(orow + 8 * g4) = w0; *(u32x2*)(orow + 32 + 8 * g4) = w1;
                }
            }
        }
        {
            const int c0 = 8 * lane;
            float cw[3][8];
#pragma unroll
            for (int j = 0; j < 3; ++j) { const f32x4 w0 = *(const f32x4*)(a.conv_w + j * 512 + c0), w1 = *(const f32x4*)(a.conv_w + j * 512 + c0 + 4);
#pragma unroll
                for (int i = 0; i < 4; ++i) { cw[j][i] = w0[i]; cw[j][4 + i] = w1[i]; } }
            const int tbase = blk * 128 + wave * 16;
            float u2[8], u1[8];
            {
                u32x4 hu[2];
#pragma unroll
                for (int i = 0; i < 2; ++i) { const int tpos = tbase - 2 + i; const size_t row = tpos >= 0 ? (size_t)(b * SEQ + tpos) : (size_t)(MTOK + NMETA + tpos);
                    hu[i] = *(const u32x4*)(PROJ + row * NPROJ + COL_U + c0); }
#pragma unroll
                for (int j = 0; j < 4; ++j) { u2[2 * j] = bflo(hu[0][j]); u2[2 * j + 1] = bfhi(hu[0][j]); u1[2 * j] = bflo(hu[1][j]); u1[2 * j + 1] = bfhi(hu[1][j]); }
            }
            u32x4 rb[4], ru[4];
#pragma unroll
            for (int i = 0; i < 4; ++i) { const bf16* p = PROJ + (size_t)(b * SEQ + tbase + i) * NPROJ + c0; rb[i] = __builtin_nontemporal_load((const u32x4*)(p + COL_CB)); ru[i] = __builtin_nontemporal_load((const u32x4*)(p + COL_U)); }
#pragma unroll
            for (int g = 0; g < 4; ++g) {
                u32x4 nb[4], nu[4];
                if (g < 3) {
#pragma unroll
                    for (int i = 0; i < 4; ++i) { const bf16* p = PROJ + (size_t)(b * SEQ + tbase + 4 * g + 4 + i) * NPROJ + c0; nb[i] = __builtin_nontemporal_load((const u32x4*)(p + COL_CB)); nu[i] = __builtin_nontemporal_load((const u32x4*)(p + COL_U)); }
                }
                float cv[4][8], ssq[4];
#pragma unroll
                for (int i = 0; i < 4; ++i) {
                    float u0[8];
#pragma unroll
                    for (int j = 0; j < 4; ++j) { u0[2 * j] = bflo(ru[i][j]); u0[2 * j + 1] = bfhi(ru[i][j]); }
                    float ss = 0.f;
#pragma unroll
                    for (int j = 0; j < 4; ++j) {
                        const float y0 = cw[0][2 * j] * u2[2 * j] + cw[1][2 * j] * u1[2 * j] + cw[2][2 * j] * u0[2 * j];
                        const float y1 = cw[0][2 * j + 1] * u2[2 * j + 1] + cw[1][2 * j + 1] * u1[2 * j + 1] + cw[2][2 * j + 1] * u0[2 * j + 1];
                        cv[i][2 * j] = bflo(rb[i][j]) * y0; cv[i][2 * j + 1] = bfhi(rb[i][j]) * y1; ss += cv[i][2 * j] * cv[i][2 * j] + cv[i][2 * j + 1] * cv[i][2 * j + 1]; }
                    ssq[i] = ss;
#pragma unroll
                    for (int j = 0; j < 8; ++j) { u2[j] = u1[j]; u1[j] = u0[j]; }
                }
#pragma unroll
                for (int o = 1; o < 64; o <<= 1) {
#pragma unroll
                    for (int i = 0; i < 4; ++i) ssq[i] += __shfl_xor(ssq[i], o); }
#pragma unroll
                for (int i = 0; i < 4; ++i) {
                    const float rcs = rsqrtf(ssq[i] * (1.f / 512.f) + EPS);
                    u32x4 w; w.x = pk2(cv[i][0] * rcs, cv[i][1] * rcs); w.y = pk2(cv[i][2] * rcs, cv[i][3] * rcs); w.z = pk2(cv[i][4] * rcs, cv[i][5] * rcs); w.w = pk2(cv[i][6] * rcs, cv[i][7] * rcs);
                    *(u32x4*)(MIXED + (size_t)(b * SEQ + tbase + 4 * g + i) * D + 512 + c0) = w; }
                if (g < 3) {
#pragma unroll
                    for (int i = 0; i < 4; ++i) { rb[i] = nb[i]; ru[i] = nu[i]; }
                }
            }
        }
    }
}

__device__ __forceinline__ void p4_router(const Args& a, LAS unsigned char* lds, int G) {
    const int tid = threadIdx.x, lane = tid & 63, wave = __builtin_amdgcn_readfirstlane(tid >> 6);
    const bf16* HB = (const bf16*)(a.ws + WS_HB); const bf16* Wr = (const bf16*)(a.ws + WS_WR);
    int* rowtok = (int*)(a.ws + WS_ROWTOK); float* rowrs = (float*)(a.ws + WS_ROWRS); float* rowgate = (float*)(a.ws + WS_ROWGATE); int* tokslot = (int*)(a.ws + WS_TOKSLOT);
    unsigned* gcnt = (unsigned*)(a.ws + WS_CTL) + CW_CNT;
    LAS int* lcnt = (LAS int*)(lds + LDSCTL_OFF + MISC_LCNT); LAS int* lbase = (LAS int*)(lds + LDSCTL_OFF + MISC_LBASE);
    LAS float* lg = (LAS float*)(lds + 99328 + wave * 4096);
    constexpr int WR_ROW = 2064;
    __syncthreads();
#pragma unroll
    for (int i = 0; i < 12; ++i) { const int id = i * 512 + tid, row = id >> 7, cc = id & 127;
        *(LAS u32x4*)(lds + row * WR_ROW + cc * 16) = *(const u32x4*)(Wr + (size_t)row * D + cc * 8); }
    for (int chunk = blockIdx.x; chunk < MTOK / 128; chunk += G) {
        __syncthreads();
        if (tid < NEXP) lcnt[tid] = 0;
        __syncthreads();
        const int t0 = chunk * 128 + wave * 16, r16 = lane & 15, q4 = lane >> 4;
        f32x4 acc[3];
#pragma unroll
        for (int c = 0; c < 3; ++c) acc[c] = (f32x4){0.f, 0.f, 0.f, 0.f};
        float ss = 0.f;
        const bf16* arow = HB + (size_t)(t0 + r16) * D + 8 * q4;
        const LAS unsigned char* brow = lds + r16 * WR_ROW + q4 * 16;
        u32x4 aw[32];
#pragma unroll
        for (int ks = 0; ks < 32; ++ks) aw[ks] = *(const u32x4*)(arow + ks * 32);
#pragma unroll
        for (int ks = 0; ks < 32; ++ks) {
#pragma unroll
            for (int j = 0; j < 4; ++j) { const float lo = bflo(aw[ks][j]), hh = bfhi(aw[ks][j]); ss += lo * lo + hh * hh; }
            const bf16x8 af = __builtin_bit_cast(bf16x8, aw[ks]);
#pragma unroll
            for (int c = 0; c < 3; ++c) { const bf16x8 bfr = *(const LAS bf16x8*)(brow + c * 16 * WR_ROW + ks * 64); acc[c] = __builtin_amdgcn_mfma_f32_16x16x32_bf16(af, bfr, acc[c], 0, 0, 0); }
        }
        ss += __shfl_xor(ss, 16); ss += __shfl_xor(ss, 32);
#pragma unroll
        for (int c = 0; c < 3; ++c)
#pragma unroll
            for (int i = 0; i < 4; ++i) lg[(4 * q4 + i) * 49 + 16 * c + r16] = acc[c][i];
        LDS_WAIT(); __builtin_amdgcn_wave_barrier();
        int e1 = 0, e2 = 0, p1 = 0, p2 = 0; float g1 = 0.f, g2 = 0.f, rs = 0.f;
        if (lane < 16) {
            rs = rsqrtf(ss * (1.f / D) + EPS);
            const LAS float* my = lg + lane * 49;
            float gl[4];
#pragma unroll
            for (int c = 0; c < 4; ++c) gl[c] = my[c] * rs + a.b_gr[c];
            int gi = 0; float gm = gl[0];
#pragma unroll
            for (int c = 1; c < 4; ++c) if (gl[c] > gm) { gm = gl[c]; gi = c; }
            float gs = 0.f;
#pragma unroll
            for (int c = 0; c < 4; ++c) gs += __expf(gl[c] - gm);
            const float gp = 1.0f / gs;
            float el[8];
#pragma unroll
            for (int e = 0; e < 8; ++e) el[e] = my[4 + gi * 8 + e] * rs + a.b_er[gi * 8 + e];
            int i1 = 0; float v1 = el[0];
#pragma unroll
            for (int e = 1; e < 8; ++e) if (el[e] > v1) { v1 = el[e]; i1 = e; }
            int i2 = -1; float v2 = -3.0e38f;
#pragma unroll
            for (int e = 0; e < 8; ++e) if (e != i1 && el[e] > v2) { v2 = el[e]; i2 = e; }
            const float ex = __expf(v2 - v1); const float w1 = 1.0f / (1.0f + ex), w2 = ex * w1;
            e1 = gi * 8 + i1; e2 = gi * 8 + i2; g1 = gp * w1; g2 = gp * w2;
            p1 = __hip_atomic_fetch_add(lcnt + e1, 1, __ATOMIC_RELAXED, __HIP_MEMORY_SCOPE_WORKGROUP);
            p2 = __hip_atomic_fetch_add(lcnt + e2, 1, __ATOMIC_RELAXED, __HIP_MEMORY_SCOPE_WORKGROUP);
        }
        __syncthreads();
        if (tid < NEXP) { const int n = lcnt[tid]; int base = 0; if (n > 0) base = (int)__hip_atomic_fetch_add(gcnt + 64 * tid, (unsigned)n, __ATOMIC_RELAXED, __HIP_MEMORY_SCOPE_AGENT); lbase[tid] = base; }
        __syncthreads();
        if (lane < 16) {
            const int tok = t0 + lane;
            const int s1 = e1 * ECAP + lbase[e1] + p1, s2 = e2 * ECAP + lbase[e2] + p2;
            rowtok[s1] = tok; rowrs[s1] = rs; rowgate[s1] = g1;
            rowtok[s2] = tok; rowrs[s2] = rs; rowgate[s2] = g2;
            tokslot[2 * tok] = s1; tokslot[2 * tok + 1] = s2;
        }
    }
}

__device__ __forceinline__ int moe_tables(const Args& a, LAS unsigned char* lds) {
    LAS int* tstart = (LAS int*)(lds + LDSCTL_OFF + MISC_TSTART); LAS int* cnt = (LAS int*)(lds + LDSCTL_OFF + MISC_CNT);
    unsigned* gcnt = (unsigned*)(a.ws + WS_CTL) + CW_CNT;
    __syncthreads();
    if (threadIdx.x == 0) { int s = 0;
        for (int e = 0; e < NEXP; ++e) { const int c = (int)__hip_atomic_load(gcnt + 64 * e, __ATOMIC_RELAXED, __HIP_MEMORY_SCOPE_AGENT); cnt[e] = c; tstart[e] = s; s += (c + 255) >> 8; }
        tstart[NEXP] = s; }
    __syncthreads();
    return tstart[NEXP];
}

#define PH(k, call) do { if (AMP_PHASE == (k)) amp_t0 = __builtin_amdgcn_s_memrealtime(); call; xcd_barrier(bar); if (AMP_PHASE == (k)) amp_t1 = __builtin_amdgcn_s_memrealtime(); if (REP_PHASE == (k)) { call; xcd_barrier(bar); } } while (0)
__device__ __forceinline__ void ph_inproj(const Args& a, LAS unsigned char* lds, int G, unsigned long long& amp_t0, unsigned long long& amp_t1) {
    unsigned char* ws = a.ws;
    pg8::Gemm g{(const bf16*)(ws + WS_XB), (const bf16*)(ws + WS_WIN), D};
    pg8::StaticOrder S; S.init(MROWS, NPROJ, D, G, (int)blockIdx.x);
    pg8::EpiProj E{(bf16*)(ws + WS_PROJ), (const float*)(ws + WS_RSX)};
    constexpr int NU = (MROWS / 256) * (NPROJ / 256);
    constexpr int GU_ITEMS = 8192, GU_STATIC = 5120;
    const int slot = conv_slot(NU, G, (int)blockIdx.x);
    if (slot >= 0) { S.i1 = slot; pg8::gemm_phase<false>(lds, g, S, E); conv_mine(a, 0, NU, G, (int)blockIdx.x, GU_STATIC); S.i0 = slot; S.i1 = 1 << 24; pg8::gemm_phase<false>(lds, g, S, E); }
    else { pg8::gemm_phase<false>(lds, g, S, E); if (slot == -2) conv_mine(a, 0, NU, G, (int)blockIdx.x, GU_STATIC); }
    conv_dyn(a, 0, GU_STATIC, GU_ITEMS, lds, (unsigned*)(ws + WS_CTL) + CW_Q);
}
__device__ __forceinline__ void ph_outproj(const Args& a, LAS unsigned char* lds, int G) {
    unsigned char* ws = a.ws;
    pg8::Gemm g{(const bf16*)(ws + WS_MIXED), (const bf16*)(ws + WS_WOUT), D};
    pg8::StaticOrder S; S.init(MTOK, D, D, G, (int)blockIdx.x);
    pg8::EpiOut E{(const bf16*)(ws + WS_XB), (bf16*)(ws + WS_HB), (unsigned char*)(ws + WS_HB8)};
    pg8::gemm_phase<false>(lds, g, S, E);
}
__device__ __forceinline__ void ph_gateup(const Args& a, LAS unsigned char* lds, int G) {
    unsigned char* ws = a.ws;
    const int T = moe_tables(a, lds);
    pg8::Gemm g{(const bf16*)(ws + WS_HB8), (const bf16*)(ws + WS_WGU), D / 2};
    pg8::MoeOrder S{(const LAS int*)(lds + LDSCTL_OFF + MISC_TSTART), (const LAS int*)(lds + LDSCTL_OFF + MISC_CNT), (const int*)(ws + WS_ROWTOK), T, G, moe_cpos((int)blockIdx.x, G), D / 2, 0, 1 << 24};
    pg8::EpiSwiglu E{(unsigned char*)(ws + WS_HID), (const float*)(ws + WS_ROWRS)};
    const int cp = moe_cpos((int)blockIdx.x, G);
    const int slot = conv_slot(4 * T, G, cp);
    if (slot >= 0) { S.i1 = slot; pg8::gemm_phase<true>(lds, g, S, E); conv_mine(a, 1, 4 * T, G, cp, 4096); S.i0 = slot; S.i1 = 1 << 24; pg8::gemm_phase<true>(lds, g, S, E); }
    else { pg8::gemm_phase<true>(lds, g, S, E); if (slot == -2) conv_mine(a, 1, 4 * T, G, cp, 4096); }
}
__device__ __forceinline__ void ph_down(const Args& a, LAS unsigned char* lds, int G) {
    unsigned char* ws = a.ws;
    const int T = moe_tables(a, lds);
    pg8::Gemm g{(const bf16*)(ws + WS_HID), (const bf16*)(ws + WS_WD), DEXP / 2};
    pg8::MoeOrder S{(const LAS int*)(lds + LDSCTL_OFF + MISC_TSTART), (const LAS int*)(lds + LDSCTL_OFF + MISC_CNT), nullptr, T, G, moe_cpos((int)blockIdx.x, G), DEXP / 2, 0, 1 << 24};
    pg8::EpiDown E{(unsigned char*)(ws + WS_YBUF), (const float*)(ws + WS_ROWGATE)};
    pg8::gemm_phase<true>(lds, g, S, E);
}
__device__ __forceinline__ void combine_store(float* o8, const u32x4& h, const u32x2& ya, const u32x2& yb) {
    const f32x2_t p0 = __builtin_amdgcn_cvt_pk_f32_fp8((int)ya.x, false), p1 = __builtin_amdgcn_cvt_pk_f32_fp8((int)ya.x, true), p2 = __builtin_amdgcn_cvt_pk_f32_fp8((int)ya.y, false), p3 = __builtin_amdgcn_cvt_pk_f32_fp8((int)ya.y, true);
    const f32x2_t r0 = __builtin_amdgcn_cvt_pk_f32_fp8((int)yb.x, false), r1 = __builtin_amdgcn_cvt_pk_f32_fp8((int)yb.x, true), r2 = __builtin_amdgcn_cvt_pk_f32_fp8((int)yb.y, false), r3 = __builtin_amdgcn_cvt_pk_f32_fp8((int)yb.y, true);
    f32x4 o0, o1;
    o0[0] = bflo(h.x) + (p0[0] + r0[0]) * Y8_INV; o0[1] = bfhi(h.x) + (p0[1] + r0[1]) * Y8_INV; o0[2] = bflo(h.y) + (p1[0] + r1[0]) * Y8_INV; o0[3] = bfhi(h.y) + (p1[1] + r1[1]) * Y8_INV;
    o1[0] = bflo(h.z) + (p2[0] + r2[0]) * Y8_INV; o1[1] = bfhi(h.z) + (p2[1] + r2[1]) * Y8_INV; o1[2] = bflo(h.w) + (p3[0] + r3[0]) * Y8_INV; o1[3] = bfhi(h.w) + (p3[1] + r3[1]) * Y8_INV;
    __builtin_nontemporal_store(o0, (f32x4*)o8); __builtin_nontemporal_store(o1, (f32x4*)(o8 + 4));
}
__device__ __forceinline__ void ph_combine(const Args& a, LAS unsigned char* lds, int G) {
    unsigned char* ws = a.ws;
    const int lane = threadIdx.x & 63, wave = threadIdx.x >> 6;
    const LAS int* tstart = (const LAS int*)(lds + LDSCTL_OFF + MISC_TSTART);
    const int* tokslot = (const int*)(ws + WS_TOKSLOT); const unsigned char* Y = ws + WS_YBUF; const bf16* HBp = (const bf16*)(ws + WS_HB);
    const int gw = blockIdx.x * 8 + wave, NGW = G * 8;
    for (int tb = gw; tb < MTOK; tb += 16 * NGW) {
        int mys0 = 0, mys1 = 0;
        { const int t = tb + (lane & 15) * NGW; if (t < MTOK) { const u32x2 sl = *(const u32x2*)(tokslot + 2 * t); mys0 = (int)sl.x; mys1 = (int)sl.y; } }
#pragma unroll
        for (int i = 0; i < 16; i += 2) {
            const int ta = tb + i * NGW, tc = tb + (i + 1) * NGW;
            if (ta >= MTOK) break;
            const bool two = tc < MTOK;
            const int a0 = __builtin_amdgcn_readlane(mys0, i), a1 = __builtin_amdgcn_readlane(mys1, i), c0 = __builtin_amdgcn_readlane(mys0, i + 1), c1 = __builtin_amdgcn_readlane(mys1, i + 1);
            const size_t ra0 = (size_t)(tstart[a0 >> 15] * 256 + (a0 & (ECAP - 1))), ra1 = (size_t)(tstart[a1 >> 15] * 256 + (a1 & (ECAP - 1)));
            const size_t rc0 = (size_t)(tstart[c0 >> 15] * 256 + (c0 & (ECAP - 1))), rc1 = (size_t)(tstart[c1 >> 15] * 256 + (c1 & (ECAP - 1)));
            u32x4 h[2][2]; u32x2 y0[2][2], y1[2][2];
#pragma unroll
            for (int j = 0; j < 2; ++j) { const int c = 8 * lane + 512 * j;
                h[0][j] = __builtin_nontemporal_load((const u32x4*)(HBp + (size_t)ta * D + c)); y0[0][j] = __builtin_nontemporal_load((const u32x2*)(Y + ra0 * D + c)); y1[0][j] = __builtin_nontemporal_load((const u32x2*)(Y + ra1 * D + c));
                h[1][j] = h[0][j]; y0[1][j] = y0[0][j]; y1[1][j] = y1[0][j];
                if (two) { h[1][j] = __builtin_nontemporal_load((const u32x4*)(HBp + (size_t)tc * D + c)); y0[1][j] = __builtin_nontemporal_load((const u32x2*)(Y + rc0 * D + c)); y1[1][j] = __builtin_nontemporal_load((const u32x2*)(Y + rc1 * D + c)); } }
#pragma unroll
            for (int j = 0; j < 2; ++j) { const int c = 8 * lane + 512 * j;
                combine_store(a.out + (size_t)ta * D + c, h[0][j], y0[0][j], y1[0][j]);
                if (two) combine_store(a.out + (size_t)tc * D + c, h[1][j], y0[1][j], y1[1][j]); }
        }
    }
}

#ifndef REP_PHASE
#define REP_PHASE -1
#endif
__global__ void __launch_bounds__(512, 2) hymba_fwd(Args a) {
    extern __shared__ __attribute__((aligned(16))) unsigned char lds_raw[];
    LAS unsigned char* lds = (LAS unsigned char*)lds_raw;
    const int tid = threadIdx.x, lane = tid & 63, wave = tid >> 6;
    const int G = gridDim.x;
    unsigned char* ws = a.ws;
    for (int u = tid; u < (LDS_BYTES - LDSCTL_OFF) / 4; u += 512) ((LAS unsigned*)(lds + LDSCTL_OFF))[u] = 0u;
    __syncthreads();
    XcdBarrier bar = xcd_barrier_post((unsigned*)(ws + WS_CTL) + CW_BAR, (volatile LAS unsigned*)(lds + LDSCTL_OFF + MISC_BAR));

    unsigned long long amp_t0 = 0, amp_t1 = 0;
    PH(0, p0_prologue(a, lds, G));
    PH(1, ph_inproj(a, lds, G, amp_t0, amp_t1));
    PH(2, p2_attn_conv(a, lds, G));
    PH(3, ph_outproj(a, lds, G));
    PH(4, p4_router(a, lds, G));
    PH(5, ph_gateup(a, lds, G));
    PH(6, ph_down(a, lds, G));
    if (AMP_PHASE == 7) amp_t0 = __builtin_amdgcn_s_memrealtime();
    ph_combine(a, lds, G);
    if (AMP_PHASE == 7) { xcd_barrier(bar); amp_t1 = __builtin_amdgcn_s_memrealtime(); }
    if (AMP_PHASE >= 0 && amp_t1 > amp_t0) { const unsigned long long span = (amp_t1 - amp_t0) * AMP_N, tw = __builtin_amdgcn_s_memrealtime(); while (__builtin_amdgcn_s_memrealtime() - tw < span) __builtin_amdgcn_s_sleep(8); }
#if REP_PHASE == 7
    xcd_barrier(bar); ph_combine(a, lds, G);
#endif
}

extern "C" void kernel_launch(void* const* d_in, const int* in_sizes, int n_in, void* d_out, int out_size, void* d_ws, size_t ws_size, hipStream_t stream) {
    static int grid = 0;
    if (grid == 0) {
        if (n_in != 20 || in_sizes[0] != MTOK * D || out_size != MTOK * D || ws_size < WS_END) {
            fprintf(stderr, "kernel_launch: unexpected shapes (n_in %d, in0 %d, out %d, ws %zu; need ws >= %zu); nothing launched\n", n_in, n_in > 0 ? in_sizes[0] : -1, out_size, ws_size, (size_t)WS_END);
            grid = -1; return; }
        int dev = 0, cus = 0;
        if (hipGetDevice(&dev) != hipSuccess || hipDeviceGetAttribute(&cus, hipDeviceAttributeMultiprocessorCount, dev) != hipSuccess) { grid = -1; return; }
        if (hipFuncSetAttribute((const void*)hymba_fwd, hipFuncAttributeMaxDynamicSharedMemorySize, LDS_BYTES) != hipSuccess) { fprintf(stderr, "kernel_launch: hipFuncSetAttribute failed\n"); grid = -1; return; }
        int per_cu = 0;
        if (hipOccupancyMaxActiveBlocksPerMultiprocessor(&per_cu, (const void*)hymba_fwd, 512, LDS_BYTES) != hipSuccess || per_cu < 1) { fprintf(stderr, "kernel_launch: occupancy query reports %d\n", per_cu); }
        (void)hipGetLastError();
        grid = cus;
    }
    if (grid < 0) return;
    if (hipMemsetAsync((char*)d_ws + WS_CTL, 0, CTL_BYTES, stream) != hipSuccess) return;
    Args a{};
    a.x = (const float*)d_in[0]; a.meta = (const float*)d_in[1]; a.rel_bias = (const float*)d_in[2]; a.mix_g = (const float*)d_in[3]; a.w_in = (const float*)d_in[4];
    a.q_g = (const float*)d_in[5]; a.k_g = (const float*)d_in[6]; a.sinks = (const float*)d_in[7]; a.conv_w = (const float*)d_in[8]; a.ga = (const float*)d_in[9];
    a.gc = (const float*)d_in[10]; a.w_out = (const float*)d_in[11]; a.ffn_g = (const float*)d_in[12]; a.w_gr = (const float*)d_in[13]; a.b_gr = (const float*)d_in[14];
    a.w_er = (const float*)d_in[15]; a.b_er = (const float*)d_in[16]; a.w_gate = (const float*)d_in[17]; a.w_up = (const float*)d_in[18]; a.w_down = (const float*)d_in[19];
    a.out = (float*)d_out; a.ws = (unsigned char*)d_ws;
    hipLaunchKernelGGL(hymba_fwd, dim3(grid), dim3(512), LDS_BYTES, stream, a);
}
```

```cpp
#include <hip/hip_runtime.h>
#include <cstdio>
#include <cstdint>
#ifndef AMP_PHASE
#define AMP_PHASE -1
#endif
#define AMP_N 4

#define LAS __attribute__((address_space(3)))
#define GAS __attribute__((address_space(1)))
typedef unsigned short bf16;
typedef short bf16x8 __attribute__((ext_vector_type(8)));
typedef short bf16x16_t __attribute__((ext_vector_type(16)));
typedef float f32x4 __attribute__((ext_vector_type(4)));
typedef float f32x16 __attribute__((ext_vector_type(16)));
typedef unsigned u32x4 __attribute__((ext_vector_type(4)));
typedef unsigned u32x2 __attribute__((ext_vector_type(2)));
typedef float f32x2_t __attribute__((ext_vector_type(2)));
typedef __bf16 bf16x2_t __attribute__((ext_vector_type(2)));

constexpr int NB = 4, SEQ = 8192, D = 1024, NMETA = 16;
constexpr int MTOK = NB * SEQ;
constexpr int MROWS = MTOK + 256;
constexpr int NPROJ = 2304;
constexpr int COL_K = 512, COL_V = 640, COL_CB = 768, COL_U = 1280;
constexpr int NEXP = 32, DEXP = 512, ECAP = 32768;
constexpr int MAXTILES = 288;
constexpr float EPS = 1e-6f;
constexpr float LOG2E = 1.4426950408889634f;

constexpr size_t MiB = 1u << 20;
constexpr size_t WS_CTL = 0, CTL_BYTES = 128 * 1024;
constexpr size_t WS_ROWTOK = 1 * MiB;
constexpr size_t WS_ROWRS = 5 * MiB;
constexpr size_t WS_ROWGATE = 9 * MiB;
constexpr size_t WS_TOKSLOT = 13 * MiB;
constexpr size_t WS_RSX = 13 * MiB + 512 * 1024;
constexpr size_t WS_WR = 14 * MiB;
constexpr size_t WS_WIN = 15 * MiB;
constexpr size_t WS_WOUT = 20 * MiB;
constexpr size_t WS_WGU = 22 * MiB;
constexpr size_t WS_HB8 = 54 * MiB;
constexpr size_t WS_WD = 86 * MiB;
constexpr size_t WS_XB = 118 * MiB;
constexpr size_t WS_PROJ = 184 * MiB;
constexpr size_t WS_HB = WS_PROJ;
constexpr size_t WS_HID = WS_PROJ + 64 * MiB;
constexpr size_t WS_YBUF = 332 * MiB;
constexpr size_t WS_MIXED = WS_YBUF;
constexpr size_t WS_END = 476 * MiB;
static_assert(WS_XB + (size_t)MROWS * D * 2 <= WS_PROJ && WS_PROJ + (size_t)MROWS * NPROJ * 2 <= WS_YBUF && WS_HID + (size_t)MAXTILES * 256 * DEXP * 2 <= WS_YBUF &&
              WS_YBUF + (size_t)MAXTILES * 256 * D * 2 <= WS_END, "d_ws map");
constexpr int CW_BAR = 4096;
constexpr int CW_CNT = 16384;
constexpr int CW_Q = 20480;

constexpr int LDS_BYTES = 147456;
constexpr int RING_BYTES = 131072;
constexpr int LDSCTL_OFF = 146432;
constexpr int SCAL_OFF = 142336;
constexpr int MISC_BAR = 0, MISC_TSTART = 64, MISC_CNT = 256, MISC_LCNT = 384, MISC_LBASE = 512;
constexpr int KN_OFF = 0, KN_HEAD = 32768;
constexpr int VT_OFF = 65536, VT_ROW = 528, VT_HEAD = 64 * VT_ROW;
constexpr int BIAS_OFF = VT_OFF + 2 * VT_HEAD;
constexpr int SSA_OFF = BIAS_OFF + 6144;
static_assert(SSA_OFF + 4096 <= LDSCTL_OFF, "P2 LDS map");

__device__ __forceinline__ unsigned pk2(float lo, float hi) { f32x2_t v = {lo, hi}; bf16x2_t b = __builtin_convertvector(v, bf16x2_t); return __builtin_bit_cast(unsigned, b); }
typedef int v8i_t __attribute__((ext_vector_type(8)));
typedef int v4i_t __attribute__((ext_vector_type(4)));
constexpr float Y8_SCALE = 16.0f, Y8_INV = 1.0f / 16.0f;
constexpr float W8_SCALE = 32.0f, W8_INV = 1.0f / 32.0f;
__device__ __forceinline__ unsigned pk4_fp8(float a, float b, float c, float d) { int w = 0; w = __builtin_amdgcn_cvt_pk_fp8_f32(a, b, w, false); w = __builtin_amdgcn_cvt_pk_fp8_f32(c, d, w, true); return (unsigned)w; }
__device__ __forceinline__ float bflo(unsigned w) { return __uint_as_float(w << 16); }
__device__ __forceinline__ float bfhi(unsigned w) { return __uint_as_float(w & 0xffff0000u); }
__device__ __forceinline__ float wave_sum(float v) {
#pragma unroll
    for (int o = 1; o < 64; o <<= 1) v += __shfl_xor(v, o);
    return v;
}
#define LDS_WAIT() asm volatile("s_waitcnt lgkmcnt(0)" ::: "memory")
#define VM_WAIT() asm volatile("s_waitcnt vmcnt(0)" ::: "memory")

#define XB_TMO      128
#define XB_XCNT(j)  (256  + 64 * (j))
#define XB_XSUB(j)  (1280 + 64 * (j))
#define XB_XGEN(j)  (2304 + 64 * (j))
#define XB_TOP      3328
#define XB_TOPGEN   3392
#define XCD_BAR_WORDS 3456
#define XB_SPIN_CAP (1u << 18)
__device__ __forceinline__ unsigned xb_ld(unsigned* p)              { return __hip_atomic_load(p, __ATOMIC_RELAXED, __HIP_MEMORY_SCOPE_AGENT); }
__device__ __forceinline__ unsigned xb_add(unsigned* p, unsigned v) { return __hip_atomic_fetch_add(p, v, __ATOMIC_RELAXED, __HIP_MEMORY_SCOPE_AGENT); }
__device__ __forceinline__ unsigned xb_xcc_id() { return (unsigned)__builtin_amdgcn_s_getreg((3 << 11) | 20) & 0xFu; }
#define XB_SPIN(cond, bar) do { unsigned _sp = 0; while (cond) { __builtin_amdgcn_s_sleep(1); \
    if ((++_sp & 255u) == 0u) { if (xb_ld(&(bar)[XB_TMO])) break; if (_sp > XB_SPIN_CAP) { atomicAdd(&(bar)[XB_TMO], 1u); break; } } } } while (0)
struct XcdBarrier { unsigned* bar; unsigned x; volatile LAS unsigned* st; };
__device__ __forceinline__ XcdBarrier xcd_barrier_post(unsigned* bar, volatile LAS unsigned* st) {
    XcdBarrier b; b.bar = bar; b.x = xb_xcc_id(); b.st = st;
    if (threadIdx.x == 0) (void)xb_add(&bar[XB_XCNT(b.x)], 1u);
    return b;
}
__device__ __forceinline__ void xcd_barrier_complete(unsigned* bar, unsigned x, unsigned& nloc, unsigned& nx) {
    const unsigned G = gridDim.x * gridDim.y * gridDim.z;
    unsigned sum, cnt, mine, sp = 0u;
    for (;;) {
        sum = 0u; cnt = 0u; mine = 0u;
#pragma unroll
        for (unsigned j = 0; j < 16; ++j) { const unsigned c = xb_ld(&bar[XB_XCNT(j)]); sum += c; cnt += (c > 0u) ? 1u : 0u; mine = (j == x) ? c : mine; }
        if (sum == G) break;
        __builtin_amdgcn_s_sleep(1);
        if ((++sp & 255u) == 0u) { if (xb_ld(&bar[XB_TMO])) break; if (sp > XB_SPIN_CAP) { atomicAdd(&bar[XB_TMO], 1u); break; } }
    }
    nloc = mine > 0u ? mine : 1u; nx = cnt > 0u ? cnt : 1u;
}
__device__ __forceinline__ void xcd_barrier(const XcdBarrier& b) {
    asm volatile("s_waitcnt vmcnt(0)" ::: "memory");
    __syncthreads();
    if (threadIdx.x == 0) {
        unsigned* bar = b.bar;
        __builtin_amdgcn_s_waitcnt(0);
        unsigned nloc = b.st[0], nx = b.st[1];
        if (nloc == 0u) { xcd_barrier_complete(bar, b.x, nloc, nx); b.st[0] = nloc; b.st[1] = nx; }
        const unsigned old = xb_add(&bar[XB_XSUB(b.x)], 1u);
        const unsigned gen = old / nloc;
        if (old + 1u == (gen + 1u) * nloc) {
            __builtin_amdgcn_fence(__ATOMIC_RELEASE, "agent");
            asm volatile("s_waitcnt vmcnt(0)" ::: "memory");
            const unsigned og = xb_add(&bar[XB_TOP], 1u);
            const unsigned tg = og / nx;
            if (og + 1u == (tg + 1u) * nx) xb_add(&bar[XB_TOPGEN], 1u);
            else XB_SPIN(xb_ld(&bar[XB_TOPGEN]) == tg, bar);
            __builtin_amdgcn_fence(__ATOMIC_ACQUIRE, "agent");
            xb_add(&bar[XB_XGEN(b.x)], 1u);
            asm volatile("s_waitcnt vmcnt(0)" ::: "memory");
        } else {
            XB_SPIN(xb_ld(&bar[XB_XGEN(b.x)]) == gen, bar);
            __builtin_amdgcn_fence(__ATOMIC_ACQUIRE, "agent");
            asm volatile("s_waitcnt vmcnt(0)" ::: "memory");
        }
    }
    __syncthreads();
}

__device__ __forceinline__ int moe_cpos(int c, int G) { if (G != 256) return c; const int x = c & 7, q = c >> 3; return ((x * 8 + (q & 7)) << 2) + (q >> 3); }
namespace pg8 {
constexpr int BM = 256, BK = 64, HALF = 128, HTB = HALF * BK * 2, STAGE_BYTES = 8 * HTB, NXCD = 8, WGM = 8;
__host__ __device__ __forceinline__ int lds_byte(int r, int c) { const int st = (r >> 4) * 2 + (c >> 5), rr = r & 15, cc = c & 31, ob = rr * 64 + cc * 2; return st * 1024 + (ob ^ (((ob >> 9) & 1) << 5)); }
__host__ __device__ __forceinline__ void stage_rc(int b, int& R, int& C) { const int st = b / 1024, sb = b % 1024, swz = sb ^ (((sb >> 9) & 1) << 5); R = (st >> 1) * 16 + swz / 64; C = (st & 1) * 32 + (swz % 64) / 2; }
__host__ __device__ __forceinline__ int perm32(int rho) { const int n = rho >> 4, i = rho & 15; return 8 * (i >> 2) + 4 * n + (i & 3); }

struct Unit { int pm, pn, xa, xb; };
struct Gemm { const bf16* A; const bf16* Bt; int K; };

struct StaticOrder {
    int nM, nN, nwg, G, c, K, i0, i1;
    __device__ void init(int M, int N, int K_, int G_, int c_) { nM = M / BM; nN = N / BM; nwg = nM * nN; G = G_; c = c_; K = K_; i0 = 0; i1 = 1 << 24; }
    __device__ __forceinline__ bool next(int i, Unit& u) const {
        i += i0; if (i >= i1) return false;
        const long L = (long)i * G + c; if (L >= nwg) return false;
        int wgid = (int)L; { const int q = nwg / NXCD, r = nwg % NXCD, xcd = wgid % NXCD, off = wgid / NXCD; wgid = (xcd < r ? xcd * (q + 1) : r * (q + 1) + (xcd - r) * q) + off; }
        const int nig = WGM * nN, gid = wgid / nig, fm = gid * WGM, gsz = (nM - fm) < WGM ? (nM - fm) : WGM;
        u.pm = fm + ((wgid % nig) % gsz); u.pn = (wgid % nig) / gsz; u.xa = 0; u.xb = 0; return true;
    }
    __device__ __forceinline__ void aoff(const Unit& u, const int (&R)[2], const int (&C)[2], unsigned (&o)[2][2]) const {
#pragma unroll
        for (int h = 0; h < 2; ++h)
#pragma unroll
            for (int i = 0; i < 2; ++i) o[h][i] = (unsigned)((u.pm * BM + h * HALF + R[i]) * K + C[i]) * 2u;
    }
};

struct MoeOrder {
    const LAS int* tstart; const LAS int* cnt; const int* rowtok;
    int T, G, c, K, i0, i1;
    __device__ __forceinline__ bool next(int i, Unit& u) const {
        i += i0; if (i >= i1) return false;
        const int L = i * G + c; if (L >= T * 4) return false;
        const int rt = L >> 2, j = L & 3;
        int e = 0;
#pragma unroll
        for (int k = 1; k < NEXP; ++k) e += (rt >= tstart[k]) ? 1 : 0;
        u.pm = rt; u.pn = __builtin_amdgcn_readfirstlane(e * 4 + j);
        u.xa = __builtin_amdgcn_readfirstlane((rt - tstart[e]) * 256); u.xb = __builtin_amdgcn_readfirstlane(cnt[e]); return true;
    }
    __device__ __forceinline__ void aoff(const Unit& u, const int (&R)[2], const int (&C)[2], unsigned (&o)[2][2]) const {
        if (rowtok) {
            const int* rt = rowtok + (size_t)(u.pn >> 2) * ECAP;
#pragma unroll
            for (int h = 0; h < 2; ++h)
#pragma unroll
                for (int i = 0; i < 2; ++i) { const int pos = u.xa + h * HALF + R[i]; int tok = 0; if (pos < u.xb) tok = rt[pos]; o[h][i] = (unsigned)(tok * K + C[i]) * 2u; }
        } else {
#pragma unroll
            for (int h = 0; h < 2; ++h)
#pragma unroll
                for (int i = 0; i < 2; ++i) o[h][i] = (unsigned)((u.pm * BM + h * HALF + R[i]) * K + C[i]) * 2u;
        }
    }
};

template <bool FP8, class Epi, class Sched>
__device__ __forceinline__ void gemm_phase(LAS unsigned char* lds, const Gemm g, const Sched& S, const Epi& E) {
    const int tid = threadIdx.x, wid = __builtin_amdgcn_readfirstlane(tid >> 6), lane = tid & 63, wr = wid >> 2, wc = wid & 3, fr = lane & 15, fq = lane >> 4;
    const int K = g.K, nt = K / BK;
    int Rr[2], Cc[2]; unsigned voffB[2];
#pragma unroll
    for (int i = 0; i < 2; ++i) { int R, C; stage_rc(tid * 16 + i * 8192, R, C); const int Rb = (R & ~31) + perm32(R & 31); Rr[i] = R; Cc[i] = C; voffB[i] = (unsigned)(Rb * K + C) * 2u; }
    const size_t kstep = (size_t)(BK * 2);
    const size_t hstep = (size_t)HALF * K * 2;
    const size_t tstep = 2 * hstep;
    const unsigned ldsw = (unsigned)wid * 1024u;
    const int aoff = lds_byte(wr * 64 + fr, fq * 8), boff = lds_byte(wc * 32 + fr, fq * 8);
#define PG8_SA(b, h) (((b) * 2 + (h)) * HTB)
#define PG8_SB(b, h) ((4 + (b) * 2 + (h)) * HTB)
#define PG8_STAGE(bufoff, gbase, voff) do { _Pragma("unroll") for (int _i = 0; _i < 2; ++_i) \
        __builtin_amdgcn_global_load_lds((const unsigned*)((const char*)(gbase) + (voff)[_i]), (LAS unsigned*)(lds + (bufoff) + ldsw + _i * 8192), 16, 0, 0); } while (0)
#define PG8_LDA_BF(dst, b, h) do { _Pragma("unroll") for (int m = 0; m < 4; ++m) _Pragma("unroll") for (int k = 0; k < 2; ++k) dst[m][k] = *(const LAS bf16x8*)(lds + PG8_SA(b, h) + aoff + m * 2048 + k * 1024); } while (0)
#define PG8_LDB_BF(dst, b, h) do { _Pragma("unroll") for (int n = 0; n < 2; ++n) _Pragma("unroll") for (int k = 0; k < 2; ++k) dst[n][k] = *(const LAS bf16x8*)(lds + PG8_SB(b, h) + boff + n * 2048 + k * 1024); } while (0)
#define PG8_MMA_BF(ai, bj, At, Bt) do { __builtin_amdgcn_s_setprio(1); _Pragma("unroll") for (int m = 0; m < 4; ++m) _Pragma("unroll") for (int n = 0; n < 2; ++n) _Pragma("unroll") for (int k = 0; k < 2; ++k) \
        acc[ai][bj][m][n] = __builtin_amdgcn_mfma_f32_16x16x32_bf16(Bt[n][k], At[m][k], acc[ai][bj][m][n], 0, 0, 0); __builtin_amdgcn_s_setprio(0); } while (0)
#define PG8_LDA_F8(dst, b, h) do { _Pragma("unroll") for (int m = 0; m < 4; ++m) { const v4i_t lo_ = *(const LAS v4i_t*)(lds + PG8_SA(b, h) + aoff + m * 2048), hi_ = *(const LAS v4i_t*)(lds + PG8_SA(b, h) + aoff + m * 2048 + 1024); \
        dst##8[m] = __builtin_shufflevector(lo_, hi_, 0, 1, 2, 3, 4, 5, 6, 7); } } while (0)
#define PG8_LDB_F8(dst, b, h) do { _Pragma("unroll") for (int n = 0; n < 2; ++n) { const v4i_t lo_ = *(const LAS v4i_t*)(lds + PG8_SB(b, h) + boff + n * 2048), hi_ = *(const LAS v4i_t*)(lds + PG8_SB(b, h) + boff + n * 2048 + 1024); \
        dst##8[n] = __builtin_shufflevector(lo_, hi_, 0, 1, 2, 3, 4, 5, 6, 7); } } while (0)
#define PG8_MMA_F8(ai, bj, At, Bt) do { __builtin_amdgcn_s_setprio(1); _Pragma("unroll") for (int m = 0; m < 4; ++m) _Pragma("unroll") for (int n = 0; n < 2; ++n) \
        asm volatile("v_mfma_scale_f32_16x16x128_f8f6f4 %0, %1, %2, %0, %3, %3 op_sel_hi:[0,0,0]" : "+v"(acc[ai][bj][m][n]) : "v"(Bt##8[n]), "v"(At##8[m]), "v"(f8scale)); \
        __builtin_amdgcn_s_setprio(0); } while (0)
#define PG8_F8_DRAIN asm volatile("s_nop 15\n\ts_nop 15" ::: "memory")
#define PG8_LDA(dst, b, h) do { if constexpr (FP8) PG8_LDA_F8(dst, b, h); else PG8_LDA_BF(dst, b, h); } while (0)
#define PG8_LDB(dst, b, h) do { if constexpr (FP8) PG8_LDB_F8(dst, b, h); else PG8_LDB_BF(dst, b, h); } while (0)
#define PG8_MMA(ai, bj, At, Bt) do { if constexpr (FP8) PG8_MMA_F8(ai, bj, At, Bt); else PG8_MMA_BF(ai, bj, At, Bt); } while (0)
#define PG8_WAIT_V(n) asm volatile("s_waitcnt vmcnt(" #n ")" ::: "memory")
#define PG8_WAIT_L(n) asm volatile("s_waitcnt lgkmcnt(" #n ")" ::: "memory")
#define PG8_BAR __builtin_amdgcn_s_barrier()
#define PG8_SCHED __builtin_amdgcn_sched_barrier(0)
    int f8scale = 0x7F7F7F7F; asm volatile("" : "+v"(f8scale));
    Unit cur, nxt; int ui = 0;
    if (!S.next(0, cur)) return;
    f32x4 acc[2][2][4][2];
#pragma unroll
    for (int a = 0; a < 2; ++a)
#pragma unroll
        for (int b = 0; b < 2; ++b)
#pragma unroll
            for (int m = 0; m < 4; ++m)
#pragma unroll
                for (int n = 0; n < 2; ++n) acc[a][b][m][n] = (f32x4){0.f, 0.f, 0.f, 0.f};
    bf16x8 At[4][2], B0[2][2], B1[2][2];
    v8i_t At8[4], B08[2], B18[2];
    unsigned oc[2][2], on[2][2];
    S.aoff(cur, Rr, Cc, oc);
    int sl_cur = 0;
    E.pre(cur, lds + SCAL_OFF, wid, lane);
    const char* const gA = (const char*)g.A;
    const char* cB = (const char*)g.Bt + (size_t)cur.pn * tstep;
    PG8_STAGE(PG8_SB(0, 0), cB, voffB); PG8_STAGE(PG8_SB(0, 1), cB + hstep, voffB); PG8_STAGE(PG8_SA(0, 0), gA, oc[0]); PG8_STAGE(PG8_SA(0, 1), gA, oc[1]);
    if (wr == 1) PG8_BAR;
    PG8_WAIT_V(2); PG8_BAR;
    PG8_STAGE(PG8_SB(1, 0), cB + kstep, voffB); PG8_STAGE(PG8_SA(1, 0), gA + kstep, oc[0]); PG8_STAGE(PG8_SB(1, 1), cB + hstep + kstep, voffB);
    PG8_WAIT_V(6); PG8_BAR;
    for (;;) {
        const bool has_next = S.next(ui + 1, nxt);
        const int sl_nxt = sl_cur == 2 ? 0 : sl_cur + 1;
        if (has_next) { S.aoff(nxt, Rr, Cc, on); E.pre(nxt, lds + SCAL_OFF + sl_nxt * 1024, wid, lane); }
        else {
#pragma unroll
            for (int h = 0; h < 2; ++h)
#pragma unroll
                for (int i = 0; i < 2; ++i) on[h][i] = oc[h][i];
        }
        const char* nB = has_next ? (const char*)g.Bt + (size_t)nxt.pn * tstep : cB;
#pragma unroll 1
        for (int t = 0; t < nt; t += 2) {
            const bool last = (t == nt - 2);
            const char* a1 = gA + (size_t)(t + 1) * kstep;
            const char* a2 = last ? gA : gA + (size_t)(t + 2) * kstep; const char* b2 = last ? nB : cB + (size_t)(t + 2) * kstep;
            const char* a3 = a2 + kstep; const char* b3 = b2 + kstep;
            unsigned o2[2][2];
#pragma unroll
            for (int h = 0; h < 2; ++h)
#pragma unroll
                for (int i = 0; i < 2; ++i) o2[h][i] = last ? on[h][i] : oc[h][i];
            PG8_LDB(B0, 0, 0); PG8_LDB(B1, 0, 1); PG8_SCHED; PG8_LDA(At, 0, 0); PG8_STAGE(PG8_SA(1, 1), a1, oc[1]);
            PG8_WAIT_V(8); PG8_WAIT_L(0); PG8_BAR; PG8_MMA(0, 0, At, B0); PG8_MMA(0, 1, At, B1); PG8_BAR; PG8_SCHED;
            PG8_LDA(At, 0, 1); PG8_STAGE(PG8_SB(0, 0), b2, voffB); PG8_STAGE(PG8_SB(0, 1), b2 + hstep, voffB); PG8_STAGE(PG8_SA(0, 0), a2, o2[0]);
            PG8_WAIT_V(8); PG8_WAIT_L(0); PG8_BAR; PG8_MMA(1, 0, At, B0); PG8_MMA(1, 1, At, B1); PG8_BAR; PG8_SCHED;
            PG8_LDB(B0, 1, 0); PG8_LDB(B1, 1, 1); PG8_SCHED; PG8_LDA(At, 1, 0); PG8_STAGE(PG8_SA(0, 1), a2, o2[1]);
            PG8_WAIT_V(8); PG8_WAIT_L(0); PG8_BAR; PG8_MMA(0, 0, At, B0); PG8_MMA(0, 1, At, B1); PG8_BAR; PG8_SCHED;
            PG8_LDA(At, 1, 1); PG8_STAGE(PG8_SB(1, 0), b3, voffB); PG8_STAGE(PG8_SB(1, 1), b3 + hstep, voffB); PG8_STAGE(PG8_SA(1, 0), a3, o2[0]);
            PG8_WAIT_V(8); PG8_WAIT_L(0); PG8_BAR; PG8_MMA(1, 0, At, B0); PG8_MMA(1, 1, At, B1); PG8_BAR; PG8_SCHED;
        }
        if constexpr (FP8) PG8_F8_DRAIN;
        if (wr == 0) PG8_BAR;
        E(acc, cur, wr, wc, fr, fq, (const LAS float*)(lds + SCAL_OFF + sl_cur * 1024));
        if (!has_next) break;
#pragma unroll
        for (int a = 0; a < 2; ++a)
#pragma unroll
            for (int b = 0; b < 2; ++b)
#pragma unroll
                for (int m = 0; m < 4; ++m)
#pragma unroll
                    for (int n = 0; n < 2; ++n) acc[a][b][m][n] = (f32x4){0.f, 0.f, 0.f, 0.f};
        cur = nxt; cB = nB; ++ui; sl_cur = sl_nxt;
#pragma unroll
        for (int h = 0; h < 2; ++h)
#pragma unroll
            for (int i = 0; i < 2; ++i) oc[h][i] = on[h][i];
        if (wr == 1) PG8_BAR;
    }
    PG8_WAIT_V(0);
    PG8_BAR;
#undef PG8_SA
#undef PG8_SB
#undef PG8_STAGE
#undef PG8_LDA
#undef PG8_LDA_BF
#undef PG8_LDA_F8
#undef PG8_LDB_BF
#undef PG8_LDB_F8
#undef PG8_MMA_BF
#undef PG8_MMA_F8
#undef PG8_F8_DRAIN
#undef PG8_LDB
#undef PG8_MMA
#undef PG8_WAIT_V
#undef PG8_WAIT_L
#undef PG8_BAR
#undef PG8_SCHED
}

struct EpiProj {
    bf16* O; const float* rs;
    __device__ __forceinline__ void pre(const Unit& u, LAS unsigned char* slot, int wid, int lane) const {
        if (wid < 4) __builtin_amdgcn_global_load_lds((const unsigned*)(rs + u.pm * BM + wid * 64 + lane), (LAS unsigned*)(slot + wid * 256), 4, 0, 0);
    }
    __device__ __forceinline__ void operator()(const f32x4 (&acc)[2][2][4][2], const Unit& u, int wr, int wc, int fr, int fq, const LAS float* scal) const {
        const int row0 = u.pm * BM + wr * 64 + fr, col0 = u.pn * BM + wc * 32 + 8 * fq;
        float sc[2][4];
#pragma unroll
        for (int ai = 0; ai < 2; ++ai)
#pragma unroll
            for (int m = 0; m < 4; ++m) sc[ai][m] = scal[ai * HALF + wr * 64 + m * 16 + fr];
        if (u.pn >= 5) {
#pragma unroll
            for (int ai = 0; ai < 2; ++ai)
#pragma unroll
                for (int m = 0; m < 4; ++m) { const int row = row0 + ai * HALF + m * 16; const float s2 = sc[ai][m] * sc[ai][m];
                    const f32x4 v0 = acc[ai][0][m][0] * acc[ai][1][m][0] * s2, v1 = acc[ai][0][m][1] * acc[ai][1][m][1] * s2;
                    u32x4 w; w.x = pk2(v0[0], v0[1]); w.y = pk2(v0[2], v0[3]); w.z = pk2(v1[0], v1[1]); w.w = pk2(v1[2], v1[3]);
                    *(u32x4*)(O + (size_t)row * NPROJ + COL_U + (u.pn - 5) * 128 + wc * 32 + 8 * fq) = w; }
            return;
        }
#pragma unroll
        for (int ai = 0; ai < 2; ++ai)
#pragma unroll
            for (int m = 0; m < 4; ++m) { const int row = row0 + ai * HALF + m * 16; const float s = sc[ai][m]; bf16* rowp = O + (size_t)row * NPROJ + col0;
#pragma unroll
                for (int bj = 0; bj < 2; ++bj) { const f32x4 v0 = acc[ai][bj][m][0] * s, v1 = acc[ai][bj][m][1] * s;
                    u32x4 w; w.x = pk2(v0[0], v0[1]); w.y = pk2(v0[2], v0[3]); w.z = pk2(v1[0], v1[1]); w.w = pk2(v1[2], v1[3]);
                    *(u32x4*)(rowp + bj * HALF) = w; } }
    }
};
struct EpiOut {
    const bf16* xb; bf16* hb; unsigned char* hb8;
    __device__ __forceinline__ void pre(const Unit&, LAS unsigned char*, int, int) const {}
    __device__ __forceinline__ void operator()(const f32x4 (&acc)[2][2][4][2], const Unit& u, int wr, int wc, int fr, int fq, const LAS float*) const {
        const int row0 = u.pm * BM + wr * 64 + fr, col0 = u.pn * BM + wc * 32 + 8 * fq;
        u32x4 xr[2][4][2];
#pragma unroll
        for (int ai = 0; ai < 2; ++ai)
#pragma unroll
            for (int m = 0; m < 4; ++m) { const size_t off = (size_t)(row0 + ai * HALF + m * 16) * D + col0;
#pragma unroll
                for (int bj = 0; bj < 2; ++bj) xr[ai][m][bj] = *(const u32x4*)(xb + off + bj * HALF); }
#pragma unroll
        for (int ai = 0; ai < 2; ++ai)
#pragma unroll
            for (int m = 0; m < 4; ++m) { const size_t off = (size_t)(row0 + ai * HALF + m * 16) * D + col0;
#pragma unroll
                for (int bj = 0; bj < 2; ++bj) { const u32x4 xw = xr[ai][m][bj]; const f32x4 a0 = acc[ai][bj][m][0], a1 = acc[ai][bj][m][1];
                    const float h0 = bflo(xw.x) + a0[0], h1 = bfhi(xw.x) + a0[1], h2 = bflo(xw.y) + a0[2], h3 = bfhi(xw.y) + a0[3];
                    const float h4 = bflo(xw.z) + a1[0], h5 = bfhi(xw.z) + a1[1], h6 = bflo(xw.w) + a1[2], h7 = bfhi(xw.w) + a1[3];
                    u32x4 w; w.x = pk2(h0, h1); w.y = pk2(h2, h3); w.z = pk2(h4, h5); w.w = pk2(h6, h7);
                    *(u32x4*)(hb + off + bj * HALF) = w;
                    u32x2 w8; w8.x = pk4_fp8(h0, h1, h2, h3); w8.y = pk4_fp8(h4, h5, h6, h7);
                    *(u32x2*)(hb8 + off + bj * HALF) = w8; } }
    }
};
__device__ __forceinline__ float silu_mul(float g, float u) { return g * __builtin_amdgcn_rcpf(1.0f + __builtin_amdgcn_exp2f(-g * LOG2E)) * u; }
struct EpiSwiglu {
    unsigned char* hid; const float* rowrs;
    __device__ __forceinline__ void pre(const Unit& u, LAS unsigned char* slot, int wid, int lane) const {
        if (wid < 4) __builtin_amdgcn_global_load_lds((const unsigned*)(rowrs + (size_t)(u.pn >> 2) * ECAP + u.xa + wid * 64 + lane), (LAS unsigned*)(slot + wid * 256), 4, 0, 0);
    }
    __device__ __forceinline__ void operator()(const f32x4 (&acc)[2][2][4][2], const Unit& u, int wr, int wc, int fr, int fq, const LAS float* scal) const {
        const int j = u.pn & 3;
        float sc[2][4];
#pragma unroll
        for (int ai = 0; ai < 2; ++ai)
#pragma unroll
            for (int m = 0; m < 4; ++m) { const int rl = ai * HALF + wr * 64 + m * 16 + fr; sc[ai][m] = (u.xa + rl < u.xb) ? scal[rl] * W8_INV : 0.f; }
#pragma unroll
        for (int ai = 0; ai < 2; ++ai)
#pragma unroll
            for (int m = 0; m < 4; ++m) { const int rl = ai * HALF + wr * 64 + m * 16 + fr; const float s = sc[ai][m];
                const f32x4 g0 = acc[ai][0][m][0] * s, g1 = acc[ai][0][m][1] * s, u0 = acc[ai][1][m][0] * s, u1 = acc[ai][1][m][1] * s;
                u32x2 w; w.x = pk4_fp8(silu_mul(g0[0], u0[0]), silu_mul(g0[1], u0[1]), silu_mul(g0[2], u0[2]), silu_mul(g0[3], u0[3]));
                w.y = pk4_fp8(silu_mul(g1[0], u1[0]), silu_mul(g1[1], u1[1]), silu_mul(g1[2], u1[2]), silu_mul(g1[3], u1[3]));
                *(u32x2*)(hid + (size_t)(u.pm * BM + rl) * DEXP + j * 128 + wc * 32 + 8 * fq) = w; }
    }
};
struct EpiDown {
    unsigned char* y; const float* rowgate;
    __device__ __forceinline__ void pre(const Unit& u, LAS unsigned char* slot, int wid, int lane) const {
        if (wid < 4) __builtin_amdgcn_global_load_lds((const unsigned*)(rowgate + (size_t)(u.pn >> 2) * ECAP + u.xa + wid * 64 + lane), (LAS unsigned*)(slot + wid * 256), 4, 0, 0);
    }
    __device__ __forceinline__ void operator()(const f32x4 (&acc)[2][2][4][2], const Unit& u, int wr, int wc, int fr, int fq, const LAS float* scal) const {
        const int j = u.pn & 3;
        float sc[2][4];
#pragma unroll
        for (int ai = 0; ai < 2; ++ai)
#pragma unroll
            for (int m = 0; m < 4; ++m) { const int rl = ai * HALF + wr * 64 + m * 16 + fr; sc[ai][m] = (u.xa + rl < u.xb) ? scal[rl] * (W8_INV * Y8_SCALE) : 0.f; }
#pragma unroll
        for (int ai = 0; ai < 2; ++ai)
#pragma unroll
            for (int m = 0; m < 4; ++m) { const int rl = ai * HALF + wr * 64 + m * 16 + fr; const float s = sc[ai][m];
                unsigned char* rowp = y + (size_t)(u.pm * BM + rl) * D + j * BM + wc * 32 + 8 * fq;
#pragma unroll
                for (int bj = 0; bj < 2; ++bj) { const f32x4 v0 = acc[ai][bj][m][0] * s, v1 = acc[ai][bj][m][1] * s;
                    u32x2 w; w.x = pk4_fp8(v0[0], v0[1], v0[2], v0[3]); w.y = pk4_fp8(v1[0], v1[1], v1[2], v1[3]);
                    *(u32x2*)(rowp + bj * HALF) = w; } }
    }
};
}

struct Args {
    const float* x; const float* meta; const float* rel_bias; const float* mix_g; const float* w_in; const float* q_g; const float* k_g; const float* sinks;
    const float* conv_w; const float* ga; const float* gc; const float* w_out; const float* ffn_g; const float* w_gr; const float* b_gr; const float* w_er; const float* b_er;
    const float* w_gate; const float* w_up; const float* w_down;
    float* out; unsigned char* ws;
};

struct TrRegs { f32x4 v[2][8]; float sk[8]; };
template <bool SCALE>
__device__ __forceinline__ void tr_load(TrRegs& t, const float* W, int ldw, const float* ks, int k0, int n0, int lane) {
    const int q = lane & 7, kg = lane >> 3;
    const float* src = W + (size_t)(k0 + 8 * kg) * ldw + n0 + 4 * q;
#pragma unroll
    for (int hh = 0; hh < 2; ++hh)
#pragma unroll
        for (int i = 0; i < 8; ++i) t.v[hh][i] = __builtin_nontemporal_load((const f32x4*)(src + (size_t)i * ldw + 32 * hh));
    if (SCALE) { const f32x4 s0 = *(const f32x4*)(ks + k0 + 8 * kg), s1 = *(const f32x4*)(ks + k0 + 8 * kg + 4);
#pragma unroll
        for (int i = 0; i < 4; ++i) { t.sk[i] = s0[i]; t.sk[4 + i] = s1[i]; } }
    else {
#pragma unroll
        for (int i = 0; i < 8; ++i) t.sk[i] = 1.f; }
}
__device__ __forceinline__ void tr_store(const TrRegs& t, bf16* WT, int ldt, int k0, int drow0, int lane) {
    const int q = lane & 7, kg = lane >> 3;
#pragma unroll
    for (int hh = 0; hh < 2; ++hh)
#pragma unroll
        for (int ni = 0; ni < 4; ++ni) {
            u32x4 o; o.x = pk2(t.v[hh][0][ni] * t.sk[0], t.v[hh][1][ni] * t.sk[1]); o.y = pk2(t.v[hh][2][ni] * t.sk[2], t.v[hh][3][ni] * t.sk[3]);
            o.z = pk2(t.v[hh][4][ni] * t.sk[4], t.v[hh][5][ni] * t.sk[5]); o.w = pk2(t.v[hh][6][ni] * t.sk[6], t.v[hh][7][ni] * t.sk[7]);
            *(u32x4*)(WT + (size_t)(drow0 + 32 * hh + 4 * q + ni) * ldt + k0 + 8 * kg) = o; }
}
template <bool SCALE>
__device__ __forceinline__ void tr_item(const float* W, int ldw, const float* ks, bf16* WT, int ldt, int k0, int n0, int drow0, int lane) {
    TrRegs t; tr_load<SCALE>(t, W, ldw, ks, k0, n0, lane); tr_store(t, WT, ldt, k0, drow0, lane);
}

struct TrItem { f32x4 v[16]; float sk[16]; };
__device__ __forceinline__ void conv_item_load(TrItem& t, const Args& a, int pool, int it, int lane) {
    const int q = lane & 7, kg = lane >> 3;
    const float* W; int ldw, k0, n0;
    if (pool == 0) { int r = it; const int up = r >= 4096 ? 1 : 0; if (up) r -= 4096; const int e = r >> 7, qq = r & 127; k0 = 128 * (qq >> 4); n0 = 32 * (qq & 15); W = (up ? a.w_up : a.w_gate) + (size_t)e * D * DEXP; ldw = DEXP; }
    else { const int e = it >> 7, qq = it & 127; k0 = 128 * (qq >> 5); n0 = 32 * (qq & 31); W = a.w_down + (size_t)e * DEXP * D; ldw = D; }
    const float* src = W + (size_t)(k0 + 16 * kg) * ldw + n0 + 4 * q;
#pragma unroll
    for (int i = 0; i < 16; ++i) t.v[i] = *(const f32x4*)(src + (size_t)i * ldw);
    if (pool == 0) {
#pragma unroll
        for (int i4 = 0; i4 < 4; ++i4) { const f32x4 sv = *(const f32x4*)(a.ffn_g + k0 + 16 * kg + 4 * i4);
#pragma unroll
            for (int i = 0; i < 4; ++i) t.sk[4 * i4 + i] = sv[i] * W8_SCALE; }
    } else {
#pragma unroll
        for (int i = 0; i < 16; ++i) t.sk[i] = W8_SCALE;
    }
}
__device__ __forceinline__ void conv_item_store(const TrItem& t, const Args& a, int pool, int it, int lane) {
    const int q = lane & 7, kg = lane >> 3;
    unsigned char* WT; int ldt, k0, drow0;
    if (pool == 0) { int r = it; const int up = r >= 4096 ? 1 : 0; if (up) r -= 4096; const int e = r >> 7, qq = r & 127, n0 = 32 * (qq & 15); k0 = 128 * (qq >> 4);
        WT = a.ws + WS_WGU; ldt = D; drow0 = e * 1024 + (n0 >> 7) * 256 + up * 128 + (n0 & 127); }
    else { const int e = it >> 7, qq = it & 127; k0 = 128 * (qq >> 5); WT = a.ws + WS_WD; ldt = DEXP; drow0 = e * 1024 + 32 * (qq & 31); }
#pragma unroll
    for (int ni = 0; ni < 4; ++ni) {
        u32x4 o;
        o.x = pk4_fp8(t.v[0][ni] * t.sk[0], t.v[1][ni] * t.sk[1], t.v[2][ni] * t.sk[2], t.v[3][ni] * t.sk[3]);
        o.y = pk4_fp8(t.v[4][ni] * t.sk[4], t.v[5][ni] * t.sk[5], t.v[6][ni] * t.sk[6], t.v[7][ni] * t.sk[7]);
        o.z = pk4_fp8(t.v[8][ni] * t.sk[8], t.v[9][ni] * t.sk[9], t.v[10][ni] * t.sk[10], t.v[11][ni] * t.sk[11]);
        o.w = pk4_fp8(t.v[12][ni] * t.sk[12], t.v[13][ni] * t.sk[13], t.v[14][ni] * t.sk[14], t.v[15][ni] * t.sk[15]);
        *(u32x4*)(WT + (size_t)(drow0 + 4 * q + ni) * ldt + k0 + 16 * kg) = o; }
}
__device__ __forceinline__ void conv_pool(const Args& a, int pool, int rank, int nranks, int total) {
    const int lane = threadIdx.x & 63, wave = threadIdx.x >> 6;
    const int gwv = rank * 8 + wave, NW = nranks * 8;
    if (gwv >= total) return;
    const int n = (total - gwv + NW - 1) / NW;
    const int last = gwv + (n - 1) * NW;
    TrItem r0, r1;
    conv_item_load(r0, a, pool, min(gwv, last), lane); conv_item_load(r1, a, pool, min(gwv + NW, last), lane);
    for (int j = 0; j < n; j += 2) {
        const int b0 = gwv + j * NW;
        conv_item_store(r0, a, pool, min(b0, last), lane);      conv_item_load(r0, a, pool, min(b0 + 2 * NW, last), lane);
        conv_item_store(r1, a, pool, min(b0 + NW, last), lane); conv_item_load(r1, a, pool, min(b0 + 3 * NW, last), lane);
    }
}
__device__ __forceinline__ int conv_slot(int nunits, int G, int c) {
    const int rem = nunits % G;
    if (rem == 0) return -2;
    if (c < rem) return -1;
    const int nmine = nunits / G;
    return (c - rem) % (nmine + 1);
}
__device__ __forceinline__ void conv_mine(const Args& a, int pool, int nunits, int G, int c, int total) {
    const int rem = nunits % G;
    if (rem == 0) conv_pool(a, pool, c, G, total); else conv_pool(a, pool, c - rem, G - rem, total);
}
__device__ __forceinline__ void conv_dyn(const Args& a, int pool, int lo, int hi, LAS unsigned char* lds, unsigned* q) {
    const int lane = threadIdx.x & 63, wave = threadIdx.x >> 6;
    volatile LAS int* tk = (volatile LAS int*)(lds + LDSCTL_OFF + 640);
    for (;;) {
        __syncthreads();
        if (threadIdx.x == 0) *tk = (int)__hip_atomic_fetch_add(q, 1u, __ATOMIC_RELAXED, __HIP_MEMORY_SCOPE_AGENT);
        __syncthreads();
        const int base = lo + (*tk) * 8;
        if (base >= hi) break;
        const int it = base + wave;
        if (it < hi) { TrItem r; conv_item_load(r, a, pool, it, lane); conv_item_store(r, a, pool, it, lane); }
    }
}

__device__ __forceinline__ void p0_prologue(const Args& a, LAS unsigned char* lds, int G) {
    const int tid = threadIdx.x, lane = tid & 63, wave = tid >> 6;
    unsigned char* ws = a.ws;
    const int gw = blockIdx.x * 8 + wave, NGW = G * 8;
    bf16* Win = (bf16*)(ws + WS_WIN); bf16* Wout = (bf16*)(ws + WS_WOUT);
    constexpr int I_IN = 16 * 36, I_OUT = 16 * 16;
    constexpr int NITEMS = I_IN + I_OUT;
    for (int it = gw; it < NITEMS; it += NGW) {
        int r = it;
        if (r < I_IN) { const int kb = r / 36, nb = r % 36, n0 = 64 * nb;
            int drow = n0;
            if (n0 >= 1792) { const int c = n0 - 1792; drow = 1280 + (c >> 7) * 256 + 128 + (c & 127); } else if (n0 >= 1280) { const int c = n0 - 1280; drow = 1280 + (c >> 7) * 256 + (c & 127); }
            tr_item<true>(a.w_in, NPROJ, a.mix_g, Win, D, 64 * kb, n0, drow, lane); continue; } r -= I_IN;
        { const int kb = r >> 4, nb = r & 15; const int k0 = 64 * kb; const float* ks = k0 < 512 ? a.ga : a.gc - 512;
            tr_item<true>(a.w_out, D, ks, Wout, D, k0, 64 * nb, 64 * nb, lane); }
    }
    bf16* Wr = (bf16*)(ws + WS_WR);
    for (int idx = blockIdx.x * 512 + tid; idx < 48 * 1024; idx += G * 512) { const int c = idx >> 10, k = idx & 1023;
        float v = 0.f; if (c < 4) v = a.w_gr[k * 4 + c]; else if (c < 36) v = a.w_er[k * 32 + (c - 4)];
        Wr[idx] = (bf16)(pk2(v * a.ffn_g[k], 0.f) & 0xffffu); }
    bf16* XB = (bf16*)(ws + WS_XB); float* rsx = (float*)(ws + WS_RSX);
    for (int m0 = 2 * gw; m0 < MROWS; m0 += 2 * NGW) {
        f32x4 v[2][4];
#pragma unroll
        for (int rr = 0; rr < 2; ++rr) { const int m = m0 + rr;
            if (m < MTOK + NMETA) { const float* src = m < MTOK ? a.x + (size_t)m * D : a.meta + (size_t)(m - MTOK) * D;
#pragma unroll
                for (int j = 0; j < 4; ++j) v[rr][j] = __builtin_nontemporal_load((const f32x4*)(src + 4 * lane + 256 * j));
            } else {
#pragma unroll
                for (int j = 0; j < 4; ++j) v[rr][j] = (f32x4){0.f, 0.f, 0.f, 0.f};
            } }
#pragma unroll
        for (int rr = 0; rr < 2; ++rr) { const int m = m0 + rr;
            float s = 0.f;
#pragma unroll
            for (int j = 0; j < 4; ++j) s += (v[rr][j].x * v[rr][j].x + v[rr][j].y * v[rr][j].y) + (v[rr][j].z * v[rr][j].z + v[rr][j].w * v[rr][j].w);
            s = wave_sum(s);
            if (lane == 0) rsx[m] = (m < MTOK + NMETA) ? rsqrtf(s * (1.f / D) + EPS) : 0.f;
#pragma unroll
            for (int j = 0; j < 4; ++j) { u32x2 w; w.x = pk2(v[rr][j].x, v[rr][j].y); w.y = pk2(v[rr][j].z, v[rr][j].w); *(u32x2*)(XB + (size_t)m * D + 4 * lane + 256 * j) = w; } }
    }
}

__device__ __forceinline__ int t5_bucket(int n) {
    if (n < 16) return n;
    const float v = logf((float)n * 0.0625f) * (16.0f / 2.0794415416798357f);
    int l = 16 + (int)v; return l < 31 ? l : 31;
}
__device__ __forceinline__ int crow(int r, int hi) { return (r & 3) + 8 * (r >> 2) + 4 * hi; }

__device__ __forceinline__ void p2_attn_conv(const Args& a, LAS unsigned char* lds, int G) {
    const int tid = threadIdx.x, lane = tid & 63, wave = __builtin_amdgcn_readfirstlane(tid >> 6);
    const bf16* PROJ = (const bf16*)(a.ws + WS_PROJ); bf16* MIXED = (bf16*)(a.ws + WS_MIXED);
    LAS float* biasT = (LAS float*)(lds + BIAS_OFF); LAS float* ssA = (LAS float*)(lds + SSA_OFF); LAS float* bndH = (LAS float*)(lds + SSA_OFF + 4096);
    for (int unit = blockIdx.x; unit < NB * 64; unit += G) {
        const int b = unit >> 6, blk = unit & 63;
        __syncthreads();
        u32x4 qraw[4];
        {
            const size_t qrow0 = (size_t)(b * SEQ + blk * 128 + (lane & 31));
#pragma unroll
            for (int s4 = 0; s4 < 4; ++s4) qraw[s4] = __builtin_nontemporal_load((const u32x4*)(PROJ + qrow0 * NPROJ + wave * 64 + 16 * s4 + 8 * (lane >> 5)));
        }
        const f32x4 gk0 = *(const f32x4*)(a.k_g + (tid & 7) * 8), gk1 = *(const f32x4*)(a.k_g + (tid & 7) * 8 + 4);
        const f32x4 gq0 = *(const f32x4*)(a.q_g + (tid & 7) * 8), gq1 = *(const f32x4*)(a.q_g + (tid & 7) * 8 + 4);
        const f32x4 gs0 = gk0 * gq0 * (0.125f * LOG2E), gs1 = gk1 * gq1 * (0.125f * LOG2E);
        float ggm;
        { const f32x4 p0 = gk0 * gq0, p1 = gk1 * gq1;
          ggm = fmaxf(fmaxf(fmaxf(fabsf(p0[0]), fabsf(p0[1])), fmaxf(fabsf(p0[2]), fabsf(p0[3]))), fmaxf(fmaxf(fabsf(p1[0]), fabsf(p1[1])), fmaxf(fabsf(p1[2]), fabsf(p1[3]))));
          ggm = fmaxf(ggm, __shfl_xor(ggm, 1)); ggm = fmaxf(ggm, __shfl_xor(ggm, 2)); ggm = fmaxf(ggm, __shfl_xor(ggm, 4)); }
        if (tid < 8) { float bm = a.rel_bias[tid];
            for (int bkt = 1; bkt < 32; ++bkt) bm = fmaxf(bm, a.rel_bias[bkt * 8 + tid]);
            bndH[tid] = (8.0f * 1.02f * LOG2E) * ggm + LOG2E * bm; }
#pragma unroll 1
        for (int pass = 0; pass < 2; ++pass) {
            u32x4 kraw[4], vraw[4];
#pragma unroll
            for (int i4 = 0; i4 < 4; ++i4) {
                const int idx = (pass * 4 + i4) * 512 + tid; const int chunk = idx & 7, kvh = (idx >> 3) & 1, wk = idx >> 4;
                const int tpos = blk * 128 - 128 + wk;
                const int row = tpos >= 0 ? b * SEQ + tpos : MTOK + NMETA + tpos;
                kraw[i4] = (u32x4){0u, 0u, 0u, 0u}; vraw[i4] = (u32x4){0u, 0u, 0u, 0u};
                if (tpos >= -NMETA) { const bf16* p = PROJ + (size_t)row * NPROJ + kvh * 64 + chunk * 8; kraw[i4] = *(const u32x4*)(p + COL_K); vraw[i4] = *(const u32x4*)(p + COL_V); }
            }
#pragma unroll
            for (int i4 = 0; i4 < 4; ++i4) {
                const int idx = (pass * 4 + i4) * 512 + tid; const int chunk = idx & 7, kvh = (idx >> 3) & 1, wk = idx >> 4;
                float kf[8];
#pragma unroll
                for (int j = 0; j < 4; ++j) { kf[2 * j] = bflo(kraw[i4][j]); kf[2 * j + 1] = bfhi(kraw[i4][j]); }
                float ss = 0.f;
#pragma unroll
                for (int j = 0; j < 8; ++j) ss += kf[j] * kf[j];
                ss += __shfl_xor(ss, 1); ss += __shfl_xor(ss, 2); ss += __shfl_xor(ss, 4);
                const float sc = rsqrtf(ss * (1.f / 64.f) + EPS);
                u32x4 kw;
                kw.x = pk2(kf[0] * sc * gs0[0], kf[1] * sc * gs0[1]); kw.y = pk2(kf[2] * sc * gs0[2], kf[3] * sc * gs0[3]);
                kw.z = pk2(kf[4] * sc * gs1[0], kf[5] * sc * gs1[1]); kw.w = pk2(kf[6] * sc * gs1[2], kf[7] * sc * gs1[3]);
                *(LAS u32x4*)(lds + KN_OFF + kvh * KN_HEAD + wk * 128 + ((chunk ^ (wk & 7)) << 4)) = kw;
                const int slot = ((wk & ~12) | ((wk & 4) << 1) | ((wk & 8) >> 1)) ^ (chunk << 3);
                LAS unsigned char* vt = lds + VT_OFF + kvh * VT_HEAD + (chunk * 8) * VT_ROW + slot * 2;
#pragma unroll
                for (int j = 0; j < 8; ++j) *(LAS unsigned short*)(vt + j * VT_ROW) = (unsigned short)(vraw[i4][j >> 1] >> (16 * (j & 1)));
            }
        }
        __syncthreads();
        for (int e2 = tid; e2 < 8 * 192; e2 += 512) { const int h = e2 / 192, dist = e2 % 192 - 31; biasT[e2] = (dist >= 0 && dist < 128) ? a.rel_bias[t5_bucket(dist) * 8 + h] * LOG2E - bndH[h] : -1e30f; }
        __syncthreads();
        {
            const int h = wave, kvh = wave >> 2, r = lane & 31, hi = lane >> 5;
            const LAS unsigned char* KnB = lds + KN_OFF + kvh * KN_HEAD; const LAS unsigned char* VTB = lds + VT_OFF + kvh * VT_HEAD;
            const float sink = a.sinks[h] * LOG2E - bndH[h];
            const int wkmin = (blk == 0) ? (128 - NMETA) : 0;
            for (int qi = 0; qi < 4; ++qi) {
                const size_t qrow = (size_t)(b * SEQ + blk * 128 + 32 * qi + r);
                float ss = 0.f;
#pragma unroll
                for (int s = 0; s < 4; ++s)
#pragma unroll
                    for (int j = 0; j < 4; ++j) { const float lo = bflo(qraw[s][j]), hh = bfhi(qraw[s][j]); ss += lo * lo + hh * hh; }
                ss += __shfl_xor(ss, 32);
                const float qsc = rsqrtf(ss * (1.f / 64.f) + EPS);
                bf16x8 qf[4];
#pragma unroll
                for (int s = 0; s < 4; ++s) { u32x4 w;
#pragma unroll
                    for (int j = 0; j < 4; ++j) w[j] = pk2(bflo(qraw[s][j]) * qsc, bfhi(qraw[s][j]) * qsc);
                    qf[s] = __builtin_bit_cast(bf16x8, w); }
                if (qi < 3) {
#pragma unroll
                    for (int s = 0; s < 4; ++s) qraw[s] = __builtin_nontemporal_load((const u32x4*)(PROJ + (qrow + 32) * NPROJ + h * 64 + 16 * s + 8 * hi));
                }
                const LAS float* bt = biasT + h * 192 + 31 + 128 + r - 4 * hi;
                f32x16 S[5];
#pragma unroll
                for (int k5 = 0; k5 < 5; ++k5) {
                    const int key = 32 * (qi + k5) + r;
                    f32x16 accs;
#pragma unroll
                    for (int i = 0; i < 16; ++i) accs[i] = bt[-32 * k5 - ((i & 3) + 8 * (i >> 2))];
#pragma unroll
                    for (int s = 0; s < 4; ++s) { const bf16x8 kfr = *(const LAS bf16x8*)(KnB + key * 128 + (((2 * s + hi) ^ (key & 7)) << 4));
                        accs = __builtin_amdgcn_mfma_f32_32x32x16_bf16(kfr, qf[s], accs, 0, 0, 0); }
                    S[k5] = accs;
                }
                if (blk == 0) {
#pragma unroll
                    for (int k5 = 0; k5 < 5; ++k5)
#pragma unroll
                        for (int i = 0; i < 16; ++i) if (32 * (qi + k5) + crow(i, hi) < wkmin) S[k5][i] = -1e30f;
                }
                float l = 0.f;
#pragma unroll
                for (int k5 = 0; k5 < 5; ++k5)
#pragma unroll
                    for (int i = 0; i < 16; ++i) { const float p = __builtin_amdgcn_exp2f(S[k5][i]); S[k5][i] = p; l += p; }
                l += __shfl_xor(l, 32);
                l += __builtin_amdgcn_exp2f(sink);
                f32x16 O0, O1;
#pragma unroll
                for (int i = 0; i < 16; ++i) { O0[i] = 0.f; O1[i] = 0.f; }
#pragma unroll
                for (int k5 = 0; k5 < 5; ++k5)
#pragma unroll
                    for (int s2 = 0; s2 < 2; ++s2) {
                        u32x4 pw;
#pragma unroll
                        for (int j = 0; j < 4; ++j) pw[j] = pk2(S[k5][8 * s2 + 2 * j], S[k5][8 * s2 + 2 * j + 1]);
                        const bf16x8 pf = __builtin_bit_cast(bf16x8, pw);
                        const int sl = 32 * (qi + k5) + 16 * s2 + 8 * hi;
                        const bf16x8 v0 = *(const LAS bf16x8*)(VTB + r * VT_ROW + ((sl ^ ((r >> 3) << 3)) << 1)), v1 = *(const LAS bf16x8*)(VTB + (32 + r) * VT_ROW + ((sl ^ ((4 + (r >> 3)) << 3)) << 1));
                        O0 = __builtin_amdgcn_mfma_f32_32x32x16_bf16(v0, pf, O0, 0, 0, 0);
                        O1 = __builtin_amdgcn_mfma_f32_32x32x16_bf16(v1, pf, O1, 0, 0, 0);
                    }
                const float inv = 1.0f / l;
                float so = 0.f;
#pragma unroll
                for (int i = 0; i < 16; ++i) { O0[i] *= inv; O1[i] *= inv; so += O0[i] * O0[i] + O1[i] * O1[i]; }
                so += __shfl_xor(so, 32);
                if (hi == 0) ssA[qi * 256 + r * 8 + h] = so;
                __syncthreads();
                float tot = 0.f;
#pragma unroll
                for (int hh = 0; hh < 8; ++hh) tot += ssA[qi * 256 + r * 8 + hh];
                const float rsa = rsqrtf(tot * (1.f / 512.f) + EPS);
                bf16* orow = MIXED + qrow * D + h * 64 + 4 * hi;
#pragma unroll
                for (int g4 = 0; g4 < 4; ++g4) {
                    u32x2 w0; w0.x = pk2(O0[4 * g4] * rsa, O0[4 * g4 + 1] * rsa); w0.y = pk2(O0[4 * g4 + 2] * rsa, O0[4 * g4 + 3] * rsa);
                    u32x2 w1; w1.x = pk2(O1[4 * g4] * rsa, O1[4 * g4 + 1] * rsa); w1.y = pk2(O1[4 * g4 + 2] * rsa, O1[4 * g4 + 3] * rsa);
                    *(u32x2*)(orow + 8 * g4) = w0; *(u32x2*)(orow + 32 + 8 * g4) = w1;
                }
            }
        }
        {
            const int c0 = 8 * lane;
            float cw[3][8];
#pragma unroll
            for (int j = 0; j < 3; ++j) { const f32x4 w0 = *(const f32x4*)(a.conv_w + j * 512 + c0), w1 = *(const f32x4*)(a.conv_w + j * 512 + c0 + 4);
#pragma unroll
                for (int i = 0; i < 4; ++i) { cw[j][i] = w0[i]; cw[j][4 + i] = w1[i]; } }
            const int tbase = blk * 128 + wave * 16;
            float u2[8], u1[8];
            {
                u32x4 hu[2];
#pragma unroll
                for (int i = 0; i < 2; ++i) { const int tpos = tbase - 2 + i; const size_t row = tpos >= 0 ? (size_t)(b * SEQ + tpos) : (size_t)(MTOK + NMETA + tpos);
                    hu[i] = *(const u32x4*)(PROJ + row * NPROJ + COL_U + c0); }
#pragma unroll
                for (int j = 0; j < 4; ++j) { u2[2 * j] = bflo(hu[0][j]); u2[2 * j + 1] = bfhi(hu[0][j]); u1[2 * j] = bflo(hu[1][j]); u1[2 * j + 1] = bfhi(hu[1][j]); }
            }
            u32x4 rb[4], ru[4];
#pragma unroll
            for (int i = 0; i < 4; ++i) { const bf16* p = PROJ + (size_t)(b * SEQ + tbase + i) * NPROJ + c0; rb[i] = __builtin_nontemporal_load((const u32x4*)(p + COL_CB)); ru[i] = __builtin_nontemporal_load((const u32x4*)(p + COL_U)); }
#pragma unroll
            for (int g = 0; g < 4; ++g) {
                u32x4 nb[4], nu[4];
                if (g < 3) {
#pragma unroll
                    for (int i = 0; i < 4; ++i) { const bf16* p = PROJ + (size_t)(b * SEQ + tbase + 4 * g + 4 + i) * NPROJ + c0; nb[i] = __builtin_nontemporal_load((const u32x4*)(p + COL_CB)); nu[i] = __builtin_nontemporal_load((const u32x4*)(p + COL_U)); }
                }
                float cv[4][8], ssq[4];
#pragma unroll
                for (int i = 0; i < 4; ++i) {
                    float u0[8];
#pragma unroll
                    for (int j = 0; j < 4; ++j) { u0[2 * j] = bflo(ru[i][j]); u0[2 * j + 1] = bfhi(ru[i][j]); }
                    float ss = 0.f;
#pragma unroll
                    for (int j = 0; j < 4; ++j) {
                        const float y0 = cw[0][2 * j] * u2[2 * j] + cw[1][2 * j] * u1[2 * j] + cw[2][2 * j] * u0[2 * j];
                        const float y1 = cw[0][2 * j + 1] * u2[2 * j + 1] + cw[1][2 * j + 1] * u1[2 * j + 1] + cw[2][2 * j + 1] * u0[2 * j + 1];
                        cv[i][2 * j] = bflo(rb[i][j]) * y0; cv[i][2 * j + 1] = bfhi(rb[i][j]) * y1; ss += cv[i][2 * j] * cv[i][2 * j] + cv[i][2 * j + 1] * cv[i][2 * j + 1]; }
                    ssq[i] = ss;
#pragma unroll
                    for (int j = 0; j < 8; ++j) { u2[j] = u1[j]; u1[j] = u0[j]; }
                }
#pragma unroll
                for (int o = 1; o < 64; o <<= 1) {
#pragma unroll
                    for (int i = 0; i < 4; ++i) ssq[i] += __shfl_xor(ssq[i], o); }
#pragma unroll
                for (int i = 0; i < 4; ++i) {
                    const float rcs = rsqrtf(ssq[i] * (1.f / 512.f) + EPS);
                    u32x4 w; w.x = pk2(cv[i][0] * rcs, cv[i][1] * rcs); w.y = pk2(cv[i][2] * rcs, cv[i][3] * rcs); w.z = pk2(cv[i][4] * rcs, cv[i][5] * rcs); w.w = pk2(cv[i][6] * rcs, cv[i][7] * rcs);
                    *(u32x4*)(MIXED + (size_t)(b * SEQ + tbase + 4 * g + i) * D + 512 + c0) = w; }
                if (g < 3) {
#pragma unroll
                    for (int i = 0; i < 4; ++i) { rb[i] = nb[i]; ru[i] = nu[i]; }
                }
            }
        }
    }
}

__device__ __forceinline__ void p4_router(const Args& a, LAS unsigned char* lds, int G) {
    const int tid = threadIdx.x, lane = tid & 63, wave = __builtin_amdgcn_readfirstlane(tid >> 6);
    const bf16* HB = (const bf16*)(a.ws + WS_HB); const bf16* Wr = (const bf16*)(a.ws + WS_WR);
    int* rowtok = (int*)(a.ws + WS_ROWTOK); float* rowrs = (float*)(a.ws + WS_ROWRS); float* rowgate = (float*)(a.ws + WS_ROWGATE); int* tokslot = (int*)(a.ws + WS_TOKSLOT);
    unsigned* gcnt = (unsigned*)(a.ws + WS_CTL) + CW_CNT;
    LAS int* lcnt = (LAS int*)(lds + LDSCTL_OFF + MISC_LCNT); LAS int* lbase = (LAS int*)(lds + LDSCTL_OFF + MISC_LBASE);
    LAS float* lg = (LAS float*)(lds + 99328 + wave * 4096);
    constexpr int WR_ROW = 2064;
    __syncthreads();
#pragma unroll
    for (int i = 0; i < 12; ++i) { const int id = i * 512 + tid, row = id >> 7, cc = id & 127;
        *(LAS u32x4*)(lds + row * WR_ROW + cc * 16) = *(const u32x4*)(Wr + (size_t)row * D + cc * 8); }
    for (int chunk = blockIdx.x; chunk < MTOK / 128; chunk += G) {
        __syncthreads();
        if (tid < NEXP) lcnt[tid] = 0;
        __syncthreads();
        const int t0 = chunk * 128 + wave * 16, r16 = lane & 15, q4 = lane >> 4;
        f32x4 acc[3];
#pragma unroll
        for (int c = 0; c < 3; ++c) acc[c] = (f32x4){0.f, 0.f, 0.f, 0.f};
        float ss = 0.f;
        const bf16* arow = HB + (size_t)(t0 + r16) * D + 8 * q4;
        const LAS unsigned char* brow = lds + r16 * WR_ROW + q4 * 16;
        u32x4 aw[32];
#pragma unroll
        for (int ks = 0; ks < 32; ++ks) aw[ks] = *(const u32x4*)(arow + ks * 32);
#pragma unroll
        for (int ks = 0; ks < 32; ++ks) {
#pragma unroll
            for (int j = 0; j < 4; ++j) { const float lo = bflo(aw[ks][j]), hh = bfhi(aw[ks][j]); ss += lo * lo + hh * hh; }
            const bf16x8 af = __builtin_bit_cast(bf16x8, aw[ks]);
#pragma unroll
            for (int c = 0; c < 3; ++c) { const bf16x8 bfr = *(const LAS bf16x8*)(brow + c * 16 * WR_ROW + ks * 64); acc[c] = __builtin_amdgcn_mfma_f32_16x16x32_bf16(af, bfr, acc[c], 0, 0, 0); }
        }
        ss += __shfl_xor(ss, 16); ss += __shfl_xor(ss, 32);
#pragma unroll
        for (int c = 0; c < 3; ++c)
#pragma unroll
            for (int i = 0; i < 4; ++i) lg[(4 * q4 + i) * 49 + 16 * c + r16] = acc[c][i];
        LDS_WAIT(); __builtin_amdgcn_wave_barrier();
        int e1 = 0, e2 = 0, p1 = 0, p2 = 0; float g1 = 0.f, g2 = 0.f, rs = 0.f;
        if (lane < 16) {
            rs = rsqrtf(ss * (1.f / D) + EPS);
            const LAS float* my = lg + lane * 49;
            float gl[4];
#pragma unroll
            for (int c = 0; c < 4; ++c) gl[c] = my[c] * rs + a.b_gr[c];
            int gi = 0; float gm = gl[0];
#pragma unroll
            for (int c = 1; c < 4; ++c) if (gl[c] > gm) { gm = gl[c]; gi = c; }
            float gs = 0.f;
#pragma unroll
            for (int c = 0; c < 4; ++c) gs += __expf(gl[c] - gm);
            const float gp = 1.0f / gs;
            float el[8];
#pragma unroll
            for (int e = 0; e < 8; ++e) el[e] = my[4 + gi * 8 + e] * rs + a.b_er[gi * 8 + e];
            int i1 = 0; float v1 = el[0];
#pragma unroll
            for (int e = 1; e < 8; ++e) if (el[e] > v1) { v1 = el[e]; i1 = e; }
            int i2 = -1; float v2 = -3.0e38f;
#pragma unroll
            for (int e = 0; e < 8; ++e) if (e != i1 && el[e] > v2) { v2 = el[e]; i2 = e; }
            const float ex = __expf(v2 - v1); const float w1 = 1.0f / (1.0f + ex), w2 = ex * w1;
            e1 = gi * 8 + i1; e2 = gi * 8 + i2; g1 = gp * w1; g2 = gp * w2;
            p1 = __hip_atomic_fetch_add(lcnt + e1, 1, __ATOMIC_RELAXED, __HIP_MEMORY_SCOPE_WORKGROUP);
            p2 = __hip_atomic_fetch_add(lcnt + e2, 1, __ATOMIC_RELAXED, __HIP_MEMORY_SCOPE_WORKGROUP);
        }
        __syncthreads();
        if (tid < NEXP) { const int n = lcnt[tid]; int base = 0; if (n > 0) base = (int)__hip_atomic_fetch_add(gcnt + 64 * tid, (unsigned)n, __ATOMIC_RELAXED, __HIP_MEMORY_SCOPE_AGENT); lbase[tid] = base; }
        __syncthreads();
        if (lane < 16) {
            const int tok = t0 + lane;
            const int s1 = e1 * ECAP + lbase[e1] + p1, s2 = e2 * ECAP + lbase[e2] + p2;
            rowtok[s1] = tok; rowrs[s1] = rs; rowgate[s1] = g1;
            rowtok[s2] = tok; rowrs[s2] = rs; rowgate[s2] = g2;
            tokslot[2 * tok] = s1; tokslot[2 * tok + 1] = s2;
        }
    }
}

__device__ __forceinline__ int moe_tables(const Args& a, LAS unsigned char* lds) {
    LAS int* tstart = (LAS int*)(lds + LDSCTL_OFF + MISC_TSTART); LAS int* cnt = (LAS int*)(lds + LDSCTL_OFF + MISC_CNT);
    unsigned* gcnt = (unsigned*)(a.ws + WS_CTL) + CW_CNT;
    __syncthreads();
    if (threadIdx.x == 0) { int s = 0;
        for (int e = 0; e < NEXP; ++e) { const int c = (int)__hip_atomic_load(gcnt + 64 * e, __ATOMIC_RELAXED, __HIP_MEMORY_SCOPE_AGENT); cnt[e] = c; tstart[e] = s; s += (c + 255) >> 8; }
        tstart[NEXP] = s; }
    __syncthreads();
    return tstart[NEXP];
}

#define PH(k, call) do { if (AMP_PHASE == (k)) amp_t0 = __builtin_amdgcn_s_memrealtime(); call; xcd_barrier(bar); if (AMP_PHASE == (k)) amp_t1 = __builtin_amdgcn_s_memrealtime(); if (REP_PHASE == (k)) { call; xcd_barrier(bar); } } while (0)
__device__ __forceinline__ void ph_inproj(const Args& a, LAS unsigned char* lds, int G, unsigned long long& amp_t0, unsigned long long& amp_t1) {
    unsigned char* ws = a.ws;
    pg8::Gemm g{(const bf16*)(ws + WS_XB), (const bf16*)(ws + WS_WIN), D};
    pg8::StaticOrder S; S.init(MROWS, NPROJ, D, G, (int)blockIdx.x);
    pg8::EpiProj E{(bf16*)(ws + WS_PROJ), (const float*)(ws + WS_RSX)};
    constexpr int NU = (MROWS / 256) * (NPROJ / 256);
    constexpr int GU_ITEMS = 8192, GU_STATIC = 5120;
    const int slot = conv_slot(NU, G, (int)blockIdx.x);
    if (slot >= 0) { S.i1 = slot; pg8::gemm_phase<false>(lds, g, S, E); conv_mine(a, 0, NU, G, (int)blockIdx.x, GU_STATIC); S.i0 = slot; S.i1 = 1 << 24; pg8::gemm_phase<false>(lds, g, S, E); }
    else { pg8::gemm_phase<false>(lds, g, S, E); if (slot == -2) conv_mine(a, 0, NU, G, (int)blockIdx.x, GU_STATIC); }
    conv_dyn(a, 0, GU_STATIC, GU_ITEMS, lds, (unsigned*)(ws + WS_CTL) + CW_Q);
}
__device__ __forceinline__ void ph_outproj(const Args& a, LAS unsigned char* lds, int G) {
    unsigned char* ws = a.ws;
    pg8::Gemm g{(const bf16*)(ws + WS_MIXED), (const bf16*)(ws + WS_WOUT), D};
    pg8::StaticOrder S; S.init(MTOK, D, D, G, (int)blockIdx.x);
    pg8::EpiOut E{(const bf16*)(ws + WS_XB), (bf16*)(ws + WS_HB), (unsigned char*)(ws + WS_HB8)};
    pg8::gemm_phase<false>(lds, g, S, E);
}
__device__ __forceinline__ void ph_gateup(const Args& a, LAS unsigned char* lds, int G) {
    unsigned char* ws = a.ws;
    const int T = moe_tables(a, lds);
    pg8::Gemm g{(const bf16*)(ws + WS_HB8), (const bf16*)(ws + WS_WGU), D / 2};
    pg8::MoeOrder S{(const LAS int*)(lds + LDSCTL_OFF + MISC_TSTART), (const LAS int*)(lds + LDSCTL_OFF + MISC_CNT), (const int*)(ws + WS_ROWTOK), T, G, moe_cpos((int)blockIdx.x, G), D / 2, 0, 1 << 24};
    pg8::EpiSwiglu E{(unsigned char*)(ws + WS_HID), (const float*)(ws + WS_ROWRS)};
    const int cp = moe_cpos((int)blockIdx.x, G);
    const int slot = conv_slot(4 * T, G, cp);
    if (slot >= 0) { S.i1 = slot; pg8::gemm_phase<true>(lds, g, S, E); conv_mine(a, 1, 4 * T, G, cp, 4096); S.i0 = slot; S.i1 = 1 << 24; pg8::gemm_phase<true>(lds, g, S, E); }
    else { pg8::gemm_phase<true>(lds, g, S, E); if (slot == -2) conv_mine(a, 1, 4 * T, G, cp, 4096); }
}
__device__ __forceinline__ void ph_down(const Args& a, LAS unsigned char* lds, int G) {
    unsigned char* ws = a.ws;
    const int T = moe_tables(a, lds);
    pg8::Gemm g{(const bf16*)(ws + WS_HID), (const bf16*)(ws + WS_WD), DEXP / 2};
    pg8::MoeOrder S{(const LAS int*)(lds + LDSCTL_OFF + MISC_TSTART), (const LAS int*)(lds + LDSCTL_OFF + MISC_CNT), nullptr, T, G, moe_cpos((int)blockIdx.x, G), DEXP / 2, 0, 1 << 24};
    pg8::EpiDown E{(unsigned char*)(ws + WS_YBUF), (const float*)(ws + WS_ROWGATE)};
    pg8::gemm_phase<true>(lds, g, S, E);
}
__device__ __forceinline__ void combine_store(float* o8, const u32x4& h, const u32x2& ya, const u32x2& yb) {
    const f32x2_t p0 = __builtin_amdgcn_cvt_pk_f32_fp8((int)ya.x, false), p1 = __builtin_amdgcn_cvt_pk_f32_fp8((int)ya.x, true), p2 = __builtin_amdgcn_cvt_pk_f32_fp8((int)ya.y, false), p3 = __builtin_amdgcn_cvt_pk_f32_fp8((int)ya.y, true);
    const f32x2_t r0 = __builtin_amdgcn_cvt_pk_f32_fp8((int)yb.x, false), r1 = __builtin_amdgcn_cvt_pk_f32_fp8((int)yb.x, true), r2 = __builtin_amdgcn_cvt_pk_f32_fp8((int)yb.y, false), r3 = __builtin_amdgcn_cvt_pk_f32_fp8((int)yb.y, true);
    f32x4 o0, o1;
    o0[0] = bflo(h.x) + (p0[0] + r0[0]) * Y8_INV; o0[1] = bfhi(h.x) + (p0[1] + r0[1]) * Y8_INV; o0[2] = bflo(h.y) + (p1[0] + r1[0]) * Y8_INV; o0[3] = bfhi(h.y) + (p1[1] + r1[1]) * Y8_INV;
    o1[0] = bflo(h.z) + (p2[0] + r2[0]) * Y8_INV; o1[1] = bfhi(h.z) + (p2[1] + r2[1]) * Y8_INV; o1[2] = bflo(h.w) + (p3[0] + r3[0]) * Y8_INV; o1[3] = bfhi(h.w) + (p3[1] + r3[1]) * Y8_INV;
    __builtin_nontemporal_store(o0, (f32x4*)o8); __builtin_nontemporal_store(o1, (f32x4*)(o8 + 4));
}
__device__ __forceinline__ void ph_combine(const Args& a, LAS unsigned char* lds, int G) {
    unsigned char* ws = a.ws;
    const int lane = threadIdx.x & 63, wave = threadIdx.x >> 6;
    const LAS int* tstart = (const LAS int*)(lds + LDSCTL_OFF + MISC_TSTART);
    const int* tokslot = (const int*)(ws + WS_TOKSLOT); const unsigned char* Y = ws + WS_YBUF; const bf16* HBp = (const bf16*)(ws + WS_HB);
    const int gw = blockIdx.x * 8 + wave, NGW = G * 8;
    for (int tb = gw; tb < MTOK; tb += 16 * NGW) {
        int mys0 = 0, mys1 = 0;
        { const int t = tb + (lane & 15) * NGW; if (t < MTOK) { const u32x2 sl = *(const u32x2*)(tokslot + 2 * t); mys0 = (int)sl.x; mys1 = (int)sl.y; } }
#pragma unroll
        for (int i = 0; i < 16; i += 2) {
            const int ta = tb + i * NGW, tc = tb + (i + 1) * NGW;
            if (ta >= MTOK) break;
            const bool two = tc < MTOK;
            const int a0 = __builtin_amdgcn_readlane(mys0, i), a1 = __builtin_amdgcn_readlane(mys1, i), c0 = __builtin_amdgcn_readlane(mys0, i + 1), c1 = __builtin_amdgcn_readlane(mys1, i + 1);
            const size_t ra0 = (size_t)(tstart[a0 >> 15] * 256 + (a0 & (ECAP - 1))), ra1 = (size_t)(tstart[a1 >> 15] * 256 + (a1 & (ECAP - 1)));
            const size_t rc0 = (size_t)(tstart[c0 >> 15] * 256 + (c0 & (ECAP - 1))), rc1 = (size_t)(tstart[c1 >> 15] * 256 + (c1 & (ECAP - 1)));
            u32x4 h[2][2]; u32x2 y0[2][2], y1[2][2];
#pragma unroll
            for (int j = 0; j < 2; ++j) { const int c = 8 * lane + 512 * j;
                h[0][j] = __builtin_nontemporal_load((const u32x4*)(HBp + (size_t)ta * D + c)); y0[0][j] = __builtin_nontemporal_load((const u32x2*)(Y + ra0 * D + c)); y1[0][j] = __builtin_nontemporal_load((const u32x2*)(Y + ra1 * D + c));
                h[1][j] = h[0][j]; y0[1][j] = y0[0][j]; y1[1][j] = y1[0][j];
                if (two) { h[1][j] = __builtin_nontemporal_load((const u32x4*)(HBp + (size_t)tc * D + c)); y0[1][j] = __builtin_nontemporal_load((const u32x2*)(Y + rc0 * D + c)); y1[1][j] = __builtin_nontemporal_load((const u32x2*)(Y + rc1 * D + c)); } }
#pragma unroll
            for (int j = 0; j < 2; ++j) { const int c = 8 * lane + 512 * j;
                combine_store(a.out + (size_t)ta * D + c, h[0][j], y0[0][j], y1[0][j]);
                if (two) combine_store(a.out + (size_t)tc * D + c, h[1][j], y0[1][j], y1[1][j]); }
        }
    }
}

#ifndef REP_PHASE
#define REP_PHASE -1
#endif
__global__ void __launch_bounds__(512, 2) hymba_fwd(Args a) {
    extern __shared__ __attribute__((aligned(16))) unsigned char lds_raw[];
    LAS unsigned char* lds = (LAS unsigned char*)lds_raw;
    const int tid = threadIdx.x, lane = tid & 63, wave = tid >> 6;
    const int G = gridDim.x;
    unsigned char* ws = a.ws;
    for (int u = tid; u < (LDS_BYTES - LDSCTL_OFF) / 4; u += 512) ((LAS unsigned*)(lds + LDSCTL_OFF))[u] = 0u;
    __syncthreads();
    XcdBarrier bar = xcd_barrier_post((unsigned*)(ws + WS_CTL) + CW_BAR, (volatile LAS unsigned*)(lds + LDSCTL_OFF + MISC_BAR));

    unsigned long long amp_t0 = 0, amp_t1 = 0;
    PH(0, p0_prologue(a, lds, G));
    PH(1, ph_inproj(a, lds, G, amp_t0, amp_t1));
    PH(2, p2_attn_conv(a, lds, G));
    PH(3, ph_outproj(a, lds, G));
    PH(4, p4_router(a, lds, G));
    PH(5, ph_gateup(a, lds, G));
    PH(6, ph_down(a, lds, G));
    if (AMP_PHASE == 7) amp_t0 = __builtin_amdgcn_s_memrealtime();
    ph_combine(a, lds, G);
    if (AMP_PHASE == 7) { xcd_barrier(bar); amp_t1 = __builtin_amdgcn_s_memrealtime(); }
    if (AMP_PHASE >= 0 && amp_t1 > amp_t0) { const unsigned long long span = (amp_t1 - amp_t0) * AMP_N, tw = __builtin_amdgcn_s_memrealtime(); while (__builtin_amdgcn_s_memrealtime() - tw < span) __builtin_amdgcn_s_sleep(8); }
#if REP_PHASE == 7
    xcd_barrier(bar); ph_combine(a, lds, G);
#endif
}

extern "C" void kernel_launch(void* const* d_in, const int* in_sizes, int n_in, void* d_out, int out_size, void* d_ws, size_t ws_size, hipStream_t stream) {
    static int grid = 0;
    if (grid == 0) {
        if (n_in != 20 || in_sizes[0] != MTOK * D || out_size != MTOK * D || ws_size < WS_END) {
            fprintf(stderr, "kernel_launch: unexpected shapes (n_in %d, in0 %d, out %d, ws %zu; need ws >= %zu); nothing launched\n", n_in, n_in > 0 ? in_sizes[0] : -1, out_size, ws_size, (size_t)WS_END);
            grid = -1; return; }
        int dev = 0, cus = 0;
        if (hipGetDevice(&dev) != hipSuccess || hipDeviceGetAttribute(&cus, hipDeviceAttributeMultiprocessorCount, dev) != hipSuccess) { grid = -1; return; }
        if (hipFuncSetAttribute((const void*)hymba_fwd, hipFuncAttributeMaxDynamicSharedMemorySize, LDS_BYTES) != hipSuccess) { fprintf(stderr, "kernel_launch: hipFuncSetAttribute failed\n"); grid = -1; return; }
        int per_cu = 0;
        if (hipOccupancyMaxActiveBlocksPerMultiprocessor(&per_cu, (const void*)hymba_fwd, 512, LDS_BYTES) != hipSuccess || per_cu < 1) { fprintf(stderr, "kernel_launch: occupancy query reports %d\n", per_cu); }
        (void)hipGetLastError();
        grid = cus;
    }
    if (grid < 0) return;
    if (hipMemsetAsync((char*)d_ws + WS_CTL, 0, CTL_BYTES, stream) != hipSuccess) return;
    Args a{};
    a.x = (const float*)d_in[0]; a.meta = (const float*)d_in[1]; a.rel_bias = (const float*)d_in[2]; a.mix_g = (const float*)d_in[3]; a.w_in = (const float*)d_in[4];
    a.q_g = (const float*)d_in[5]; a.k_g = (const float*)d_in[6]; a.sinks = (const float*)d_in[7]; a.conv_w = (const float*)d_in[8]; a.ga = (const float*)d_in[9];
    a.gc = (const float*)d_in[10]; a.w_out = (const float*)d_in[11]; a.ffn_g = (const float*)d_in[12]; a.w_gr = (const float*)d_in[13]; a.b_gr = (const float*)d_in[14];
    a.w_er = (const float*)d_in[15]; a.b_er = (const float*)d_in[16]; a.w_gate = (const float*)d_in[17]; a.w_up = (const float*)d_in[18]; a.w_down = (const float*)d_in[19];
    a.out = (float*)d_out; a.ws = (unsigned char*)d_ws;
    hipLaunchKernelGGL(hymba_fwd, dim3(grid), dim3(512), LDS_BYTES, stream, a);
}
```

```cpp
#include <hip/hip_runtime.h>
#include <cstdio>
#include <cstdint>
#ifndef AMP_PHASE
#define AMP_PHASE -1
#endif
#define AMP_N 4

#define LAS __attribute__((address_space(3)))
#define GAS __attribute__((address_space(1)))
typedef unsigned short bf16;
typedef short bf16x8 __attribute__((ext_vector_type(8)));
typedef short bf16x16_t __attribute__((ext_vector_type(16)));
typedef float f32x4 __attribute__((ext_vector_type(4)));
typedef float f32x16 __attribute__((ext_vector_type(16)));
typedef unsigned u32x4 __attribute__((ext_vector_type(4)));
typedef unsigned u32x2 __attribute__((ext_vector_type(2)));
typedef float f32x2_t __attribute__((ext_vector_type(2)));
typedef __bf16 bf16x2_t __attribute__((ext_vector_type(2)));

constexpr int NB = 4, SEQ = 8192, D = 1024, NMETA = 16;
constexpr int MTOK = NB * SEQ;
constexpr int MROWS = MTOK + 256;
constexpr int NPROJ = 2304;
constexpr int COL_K = 512, COL_V = 640, COL_CB = 768, COL_U = 1280;
constexpr int NEXP = 32, DEXP = 512, ECAP = 32768;
constexpr int MAXTILES = 288;
constexpr float EPS = 1e-6f;
constexpr float LOG2E = 1.4426950408889634f;

constexpr size_t MiB = 1u << 20;
constexpr size_t WS_CTL = 0, CTL_BYTES = 128 * 1024;
constexpr size_t WS_ROWTOK = 1 * MiB;
constexpr size_t WS_ROWRS = 5 * MiB;
constexpr size_t WS_ROWGATE = 9 * MiB;
constexpr size_t WS_TOKSLOT = 13 * MiB;
constexpr size_t WS_RSX = 13 * MiB + 512 * 1024;
constexpr size_t WS_WR = 14 * MiB;
constexpr size_t WS_WIN = 15 * MiB;
constexpr size_t WS_WOUT = 20 * MiB;
constexpr size_t WS_WGU = 22 * MiB;
constexpr size_t WS_HB8 = 54 * MiB;
constexpr size_t WS_WD = 86 * MiB;
constexpr size_t WS_XB = 118 * MiB;
constexpr size_t WS_PROJ = 184 * MiB;
constexpr size_t WS_HB = WS_PROJ;
constexpr size_t WS_HID = WS_PROJ + 64 * MiB;
constexpr size_t WS_YBUF = 332 * MiB;
constexpr size_t WS_MIXED = WS_YBUF;
constexpr size_t WS_END = 476 * MiB;
static_assert(WS_XB + (size_t)MROWS * D * 2 <= WS_PROJ && WS_PROJ + (size_t)MROWS * NPROJ * 2 <= WS_YBUF && WS_HID + (size_t)MAXTILES * 256 * DEXP * 2 <= WS_YBUF &&
              WS_YBUF + (size_t)MAXTILES * 256 * D * 2 <= WS_END, "d_ws map");
constexpr int CW_BAR = 4096;
constexpr int CW_CNT = 16384;
constexpr int CW_Q = 20480;

constexpr int LDS_BYTES = 147456;
constexpr int RING_BYTES = 131072;
constexpr int LDSCTL_OFF = 146432;
constexpr int SCAL_OFF = 142336;
constexpr int MISC_BAR = 0, MISC_TSTART = 64, MISC_CNT = 256, MISC_LCNT = 384, MISC_LBASE = 512;
constexpr int KN_OFF = 0, KN_HEAD = 32768;
constexpr int VT_OFF = 65536, VT_ROW = 528, VT_HEAD = 64 * VT_ROW;
constexpr int BIAS_OFF = VT_OFF + 2 * VT_HEAD;
constexpr int SSA_OFF = BIAS_OFF + 6144;
static_assert(SSA_OFF + 4096 <= LDSCTL_OFF, "P2 LDS map");

__device__ __forceinline__ unsigned pk2(float lo, float hi) { f32x2_t v = {lo, hi}; bf16x2_t b = __builtin_convertvector(v, bf16x2_t); return __builtin_bit_cast(unsigned, b); }
typedef int v8i_t __attribute__((ext_vector_type(8)));
typedef int v4i_t __attribute__((ext_vector_type(4)));
constexpr float Y8_SCALE = 16.0f, Y8_INV = 1.0f / 16.0f;
constexpr float W8_SCALE = 32.0f, W8_INV = 1.0f / 32.0f;
__device__ __forceinline__ unsigned pk4_fp8(float a, float b, float c, float d) { int w = 0; w = __builtin_amdgcn_cvt_pk_fp8_f32(a, b, w, false); w = __builtin_amdgcn_cvt_pk_fp8_f32(c, d, w, true); return (unsigned)w; }
__device__ __forceinline__ float bflo(unsigned w) { return __uint_as_float(w << 16); }
__device__ __forceinline__ float bfhi(unsigned w) { return __uint_as_float(w & 0xffff0000u); }
__device__ __forceinline__ float wave_sum(float v) {
#pragma unroll
    for (int o = 1; o < 64; o <<= 1) v += __shfl_xor(v, o);
    return v;
}
#define LDS_WAIT() asm volatile("s_waitcnt lgkmcnt(0)" ::: "memory")
#define VM_WAIT() asm volatile("s_waitcnt vmcnt(0)" ::: "memory")

#define XB_TMO      128
#define XB_XCNT(j)  (256  + 64 * (j))
#define XB_XSUB(j)  (1280 + 64 * (j))
#define XB_XGEN(j)  (2304 + 64 * (j))
#define XB_TOP      3328
#define XB_TOPGEN   3392
#define XCD_BAR_WORDS 3456
#define XB_SPIN_CAP (1u << 18)
__device__ __forceinline__ unsigned xb_ld(unsigned* p)              { return __hip_atomic_load(p, __ATOMIC_RELAXED, __HIP_MEMORY_SCOPE_AGENT); }
__device__ __forceinline__ unsigned xb_add(unsigned* p, unsigned v) { return __hip_atomic_fetch_add(p, v, __ATOMIC_RELAXED, __HIP_MEMORY_SCOPE_AGENT); }
__device__ __forceinline__ unsigned xb_xcc_id() { return (unsigned)__builtin_amdgcn_s_getreg((3 << 11) | 20) & 0xFu; }
#define XB_SPIN(cond, bar) do { unsigned _sp = 0; while (cond) { __builtin_amdgcn_s_sleep(1); \
    if ((++_sp & 255u) == 0u) { if (xb_ld(&(bar)[XB_TMO])) break; if (_sp > XB_SPIN_CAP) { atomicAdd(&(bar)[XB_TMO], 1u); break; } } } } while (0)
struct XcdBarrier { unsigned* bar; unsigned x; volatile LAS unsigned* st; };
__device__ __forceinline__ XcdBarrier xcd_barrier_post(unsigned* bar, volatile LAS unsigned* st) {
    XcdBarrier b; b.bar = bar; b.x = xb_xcc_id(); b.st = st;
    if (threadIdx.x == 0) (void)xb_add(&bar[XB_XCNT(b.x)], 1u);
    return b;
}
__device__ __forceinline__ void xcd_barrier_complete(unsigned* bar, unsigned x, unsigned& nloc, unsigned& nx) {
    const unsigned G = gridDim.x * gridDim.y * gridDim.z;
    unsigned sum, cnt, mine, sp = 0u;
    for (;;) {
        sum = 0u; cnt = 0u; mine = 0u;
#pragma unroll
        for (unsigned j = 0; j < 16; ++j) { const unsigned c = xb_ld(&bar[XB_XCNT(j)]); sum += c; cnt += (c > 0u) ? 1u : 0u; mine = (j == x) ? c : mine; }
        if (sum == G) break;
        __builtin_amdgcn_s_sleep(1);
        if ((++sp & 255u) == 0u) { if (xb_ld(&bar[XB_TMO])) break; if (sp > XB_SPIN_CAP) { atomicAdd(&bar[XB_TMO], 1u); break; } }
    }
    nloc = mine > 0u ? mine : 1u; nx = cnt > 0u ? cnt : 1u;
}
__device__ __forceinline__ void xcd_barrier(const XcdBarrier& b) {
    asm volatile("s_waitcnt vmcnt(0)" ::: "memory");
    __syncthreads();
    if (threadIdx.x == 0) {
        unsigned* bar = b.bar;
        __builtin_amdgcn_s_waitcnt(0);
        unsigned nloc = b.st[0], nx = b.st[1];
        if (nloc == 0u) { xcd_barrier_complete(bar, b.x, nloc, nx); b.st[0] = nloc; b.st[1] = nx; }
        const unsigned old = xb_add(&bar[XB_XSUB(b.x)], 1u);
        const unsigned gen = old / nloc;
        if (old + 1u == (gen + 1u) * nloc) {
            __builtin_amdgcn_fence(__ATOMIC_RELEASE, "agent");
            asm volatile("s_waitcnt vmcnt(0)" ::: "memory");
            const unsigned og = xb_add(&bar[XB_TOP], 1u);
            const unsigned tg = og / nx;
            if (og + 1u == (tg + 1u) * nx) xb_add(&bar[XB_TOPGEN], 1u);
            else XB_SPIN(xb_ld(&bar[XB_TOPGEN]) == tg, bar);
            __builtin_amdgcn_fence(__ATOMIC_ACQUIRE, "agent");
            xb_add(&bar[XB_XGEN(b.x)], 1u);
            asm volatile("s_waitcnt vmcnt(0)" ::: "memory");
        } else {
            XB_SPIN(xb_ld(&bar[XB_XGEN(b.x)]) == gen, bar);
            __builtin_amdgcn_fence(__ATOMIC_ACQUIRE, "agent");
            asm volatile("s_waitcnt vmcnt(0)" ::: "memory");
        }
    }
    __syncthreads();
}

__device__ __forceinline__ int moe_cpos(int c, int G) { if (G != 256) return c; const int x = c & 7, q = c >> 3; return ((x * 8 + (q & 7)) << 2) + (q >> 3); }
namespace pg8 {
constexpr int BM = 256, BK = 64, HALF = 128, HTB = HALF * BK * 2, STAGE_BYTES = 8 * HTB, NXCD = 8, WGM = 8;
__host__ __device__ __forceinline__ int lds_byte(int r, int c) { const int st = (r >> 4) * 2 + (c >> 5), rr = r & 15, cc = c & 31, ob = rr * 64 + cc * 2; return st * 1024 + (ob ^ (((ob >> 9) & 1) << 5)); }
__host__ __device__ __forceinline__ void stage_rc(int b, int& R, int& C) { const int st = b / 1024, sb = b % 1024, swz = sb ^ (((sb >> 9) & 1) << 5); R = (st >> 1) * 16 + swz / 64; C = (st & 1) * 32 + (swz % 64) / 2; }
__host__ __device__ __forceinline__ int perm32(int rho) { const int n = rho >> 4, i = rho & 15; return 8 * (i >> 2) + 4 * n + (i & 3); }

struct Unit { int pm, pn, xa, xb; };
struct Gemm { const bf16* A; const bf16* Bt; int K; };

struct StaticOrder {
    int nM, nN, nwg, G, c, K, i0, i1;
    __device__ void init(int M, int N, int K_, int G_, int c_) { nM = M / BM; nN = N / BM; nwg = nM * nN; G = G_; c = c_; K = K_; i0 = 0; i1 = 1 << 24; }
    __device__ __forceinline__ bool next(int i, Unit& u) const {
        i += i0; if (i >= i1) return false;
        const long L = (long)i * G + c; if (L >= nwg) return false;
        int wgid = (int)L; { const int q = nwg / NXCD, r = nwg % NXCD, xcd = wgid % NXCD, off = wgid / NXCD; wgid = (xcd < r ? xcd * (q + 1) : r * (q + 1) + (xcd - r) * q) + off; }
        const int nig = WGM * nN, gid = wgid / nig, fm = gid * WGM, gsz = (nM - fm) < WGM ? (nM - fm) : WGM;
        u.pm = fm + ((wgid % nig) % gsz); u.pn = (wgid % nig) / gsz; u.xa = 0; u.xb = 0; return true;
    }
    __device__ __forceinline__ void aoff(const Unit& u, const int (&R)[2], const int (&C)[2], unsigned (&o)[2][2]) const {
#pragma unroll
        for (int h = 0; h < 2; ++h)
#pragma unroll
            for (int i = 0; i < 2; ++i) o[h][i] = (unsigned)((u.pm * BM + h * HALF + R[i]) * K + C[i]) * 2u;
    }
};

struct MoeOrder {
    const LAS int* tstart; const LAS int* cnt; const int* rowtok;
    int T, G, c, K, i0, i1;
    __device__ __forceinline__ bool next(int i, Unit& u) const {
        i += i0; if (i >= i1) return false;
        const int L = i * G + c; if (L >= T * 4) return false;
        const int rt = L >> 2, j = L & 3;
        int e = 0;
#pragma unroll
        for (int k = 1; k < NEXP; ++k) e += (rt >= tstart[k]) ? 1 : 0;
        u.pm = rt; u.pn = __builtin_amdgcn_readfirstlane(e * 4 + j);
        u.xa = __builtin_amdgcn_readfirstlane((rt - tstart[e]) * 256); u.xb = __builtin_amdgcn_readfirstlane(cnt[e]); return true;
    }
    __device__ __forceinline__ void aoff(const Unit& u, const int (&R)[2], const int (&C)[2], unsigned (&o)[2][2]) const {
        if (rowtok) {
            const int* rt = rowtok + (size_t)(u.pn >> 2) * ECAP;
#pragma unroll
            for (int h = 0; h < 2; ++h)
#pragma unroll
                for (int i = 0; i < 2; ++i) { const int pos = u.xa + h * HALF + R[i]; int tok = 0; if (pos < u.xb) tok = rt[pos]; o[h][i] = (unsigned)(tok * K + C[i]) * 2u; }
        } else {
#pragma unroll
            for (int h = 0; h < 2; ++h)
#pragma unroll
                for (int i = 0; i < 2; ++i) o[h][i] = (unsigned)((u.pm * BM + h * HALF + R[i]) * K + C[i]) * 2u;
        }
    }
};

template <bool FP8, class Epi, class Sched>
__device__ __forceinline__ void gemm_phase(LAS unsigned char* lds, const Gemm g, const Sched& S, const Epi& E) {
    const int tid = threadIdx.x, wid = __builtin_amdgcn_readfirstlane(tid >> 6), lane = tid & 63, wr = wid >> 2, wc = wid & 3, fr = lane & 15, fq = lane >> 4;
    const int K = g.K, nt = K / BK;
    int Rr[2], Cc[2]; unsigned voffB[2];
#pragma unroll
    for (int i = 0; i < 2; ++i) { int R, C; stage_rc(tid * 16 + i * 8192, R, C); const int Rb = (R & ~31) + perm32(R & 31); Rr[i] = R; Cc[i] = C; voffB[i] = (unsigned)(Rb * K + C) * 2u; }
    const size_t kstep = (size_t)(BK * 2);
    const size_t hstep = (size_t)HALF * K * 2;
    const size_t tstep = 2 * hstep;
    const unsigned ldsw = (unsigned)wid * 1024u;
    const int aoff = lds_byte(wr * 64 + fr, fq * 8), boff = lds_byte(wc * 32 + fr, fq * 8);
#define PG8_SA(b, h) (((b) * 2 + (h)) * HTB)
#define PG8_SB(b, h) ((4 + (b) * 2 + (h)) * HTB)
#define PG8_STAGE(bufoff, gbase, voff) do { _Pragma("unroll") for (int _i = 0; _i < 2; ++_i) \
        __builtin_amdgcn_global_load_lds((const unsigned*)((const char*)(gbase) + (voff)[_i]), (LAS unsigned*)(lds + (bufoff) + ldsw + _i * 8192), 16, 0, 0); } while (0)
#define PG8_LDA_BF(dst, b, h) do { _Pragma("unroll") for (int m = 0; m < 4; ++m) _Pragma("unroll") for (int k = 0; k < 2; ++k) dst[m][k] = *(const LAS bf16x8*)(lds + PG8_SA(b, h) + aoff + m * 2048 + k * 1024); } while (0)
#define PG8_LDB_BF(dst, b, h) do { _Pragma("unroll") for (int n = 0; n < 2; ++n) _Pragma("unroll") for (int k = 0; k < 2; ++k) dst[n][k] = *(const LAS bf16x8*)(lds + PG8_SB(b, h) + boff + n * 2048 + k * 1024); } while (0)
#define PG8_MMA_BF(ai, bj, At, Bt) do { __builtin_amdgcn_s_setprio(1); _Pragma("unroll") for (int m = 0; m < 4; ++m) _Pragma("unroll") for (int n = 0; n < 2; ++n) _Pragma("unroll") for (int k = 0; k < 2; ++k) \
        acc[ai][bj][m][n] = __builtin_amdgcn_mfma_f32_16x16x32_bf16(Bt[n][k], At[m][k], acc[ai][bj][m][n], 0, 0, 0); __builtin_amdgcn_s_setprio(0); } while (0)
#define PG8_LDA_F8(dst, b, h) do { _Pragma("unroll") for (int m = 0; m < 4; ++m) { const v4i_t lo_ = *(const LAS v4i_t*)(lds + PG8_SA(b, h) + aoff + m * 2048), hi_ = *(const LAS v4i_t*)(lds + PG8_SA(b, h) + aoff + m * 2048 + 1024); \
        dst##8[m] = __builtin_shufflevector(lo_, hi_, 0, 1, 2, 3, 4, 5, 6, 7); } } while (0)
#define PG8_LDB_F8(dst, b, h) do { _Pragma("unroll") for (int n = 0; n < 2; ++n) { const v4i_t lo_ = *(const LAS v4i_t*)(lds + PG8_SB(b, h) + boff + n * 2048), hi_ = *(const LAS v4i_t*)(lds + PG8_SB(b, h) + boff + n * 2048 + 1024); \
        dst##8[n] = __builtin_shufflevector(lo_, hi_, 0, 1, 2, 3, 4, 5, 6, 7); } } while (0)
#define PG8_MMA_F8(ai, bj, At, Bt) do { __builtin_amdgcn_s_setprio(1); _Pragma("unroll") for (int m = 0; m < 4; ++m) _Pragma("unroll") for (int n = 0; n < 2; ++n) \
        asm volatile("v_mfma_scale_f32_16x16x128_f8f6f4 %0, %1, %2, %0, %3, %3 op_sel_hi:[0,0,0]" : "+v"(acc[ai][bj][m][n]) : "v"(Bt##8[n]), "v"(At##8[m]), "v"(f8scale)); \
        __builtin_amdgcn_s_setprio(0); } while (0)
#define PG8_F8_DRAIN asm volatile("s_nop 15\n\ts_nop 15" ::: "memory")
#define PG8_LDA(dst, b, h) do { if constexpr (FP8) PG8_LDA_F8(dst, b, h); else PG8_LDA_BF(dst, b, h); } while (0)
#define PG8_LDB(dst, b, h) do { if constexpr (FP8) PG8_LDB_F8(dst, b, h); else PG8_LDB_BF(dst, b, h); } while (0)
#define PG8_MMA(ai, bj, At, Bt) do { if constexpr (FP8) PG8_MMA_F8(ai, bj, At, Bt); else PG8_MMA_BF(ai, bj, At, Bt); } while (0)
#define PG8_WAIT_V(n) asm volatile("s_waitcnt vmcnt(" #n ")" ::: "memory")
#define PG8_WAIT_L(n) asm volatile("s_waitcnt lgkmcnt(" #n ")" ::: "memory")
#define PG8_BAR __builtin_amdgcn_s_barrier()
#define PG8_SCHED __builtin_amdgcn_sched_barrier(0)
    int f8scale = 0x7F7F7F7F; asm volatile("" : "+v"(f8scale));
    Unit cur, nxt; int ui = 0;
    if (!S.next(0, cur)) return;
    f32x4 acc[2][2][4][2];
#pragma unroll
    for (int a = 0; a < 2; ++a)
#pragma unroll
        for (int b = 0; b < 2; ++b)
#pragma unroll
            for (int m = 0; m < 4; ++m)
#pragma unroll
                for (int n = 0; n < 2; ++n) acc[a][b][m][n] = (f32x4){0.f, 0.f, 0.f, 0.f};
    bf16x8 At[4][2], B0[2][2], B1[2][2];
    v8i_t At8[4], B08[2], B18[2];
    unsigned oc[2][2], on[2][2];
    S.aoff(cur, Rr, Cc, oc);
    int sl_cur = 0;
    E.pre(cur, lds + SCAL_OFF, wid, lane);
    const char* const gA = (const char*)g.A;
    const char* cB = (const char*)g.Bt + (size_t)cur.pn * tstep;
    PG8_STAGE(PG8_SB(0, 0), cB, voffB); PG8_STAGE(PG8_SB(0, 1), cB + hstep, voffB); PG8_STAGE(PG8_SA(0, 0), gA, oc[0]); PG8_STAGE(PG8_SA(0, 1), gA, oc[1]);
    if (wr == 1) PG8_BAR;
    PG8_WAIT_V(2); PG8_BAR;
    PG8_STAGE(PG8_SB(1, 0), cB + kstep, voffB); PG8_STAGE(PG8_SA(1, 0), gA + kstep, oc[0]); PG8_STAGE(PG8_SB(1, 1), cB + hstep + kstep, voffB);
    PG8_WAIT_V(6); PG8_BAR;
    for (;;) {
        const bool has_next = S.next(ui + 1, nxt);
        const int sl_nxt = sl_cur == 2 ? 0 : sl_cur + 1;
        if (has_next) { S.aoff(nxt, Rr, Cc, on); E.pre(nxt, lds + SCAL_OFF + sl_nxt * 1024, wid, lane); }
        else {
#pragma unroll
            for (int h = 0; h < 2; ++h)
#pragma unroll
                for (int i = 0; i < 2; ++i) on[h][i] = oc[h][i];
        }
        const char* nB = has_next ? (const char*)g.Bt + (size_t)nxt.pn * tstep : cB;
#pragma unroll 1
        for (int t = 0; t < nt; t += 2) {
            const bool last = (t == nt - 2);
            const char* a1 = gA + (size_t)(t + 1) * kstep;
            const char* a2 = last ? gA : gA + (size_t)(t + 2) * kstep; const char* b2 = last ? nB : cB + (size_t)(t + 2) * kstep;
            const char* a3 = a2 + kstep; const char* b3 = b2 + kstep;
            unsigned o2[2][2];
#pragma unroll
            for (int h = 0; h < 2; ++h)
#pragma unroll
                for (int i = 0; i < 2; ++i) o2[h][i] = last ? on[h][i] : oc[h][i];
            PG8_LDB(B0, 0, 0); PG8_LDB(B1, 0, 1); PG8_SCHED; PG8_LDA(At, 0, 0); PG8_STAGE(PG8_SA(1, 1), a1, oc[1]);
            PG8_WAIT_V(8); PG8_WAIT_L(0); PG8_BAR; PG8_MMA(0, 0, At, B0); PG8_MMA(0, 1, At, B1); PG8_BAR; PG8_SCHED;
            PG8_LDA(At, 0, 1); PG8_STAGE(PG8_SB(0, 0), b2, voffB); PG8_STAGE(PG8_SB(0, 1), b2 + hstep, voffB); PG8_STAGE(PG8_SA(0, 0), a2, o2[0]);
            PG8_WAIT_V(8); PG8_WAIT_L(0); PG8_BAR; PG8_MMA(1, 0, At, B0); PG8_MMA(1, 1, At, B1); PG8_BAR; PG8_SCHED;
            PG8_LDB(B0, 1, 0); PG8_LDB(B1, 1, 1); PG8_SCHED; PG8_LDA(At, 1, 0); PG8_STAGE(PG8_SA(0, 1), a2, o2[1]);
            PG8_WAIT_V(8); PG8_WAIT_L(0); PG8_BAR; PG8_MMA(0, 0, At, B0); PG8_MMA(0, 1, At, B1); PG8_BAR; PG8_SCHED;
            PG8_LDA(At, 1, 1); PG8_STAGE(PG8_SB(1, 0), b3, voffB); PG8_STAGE(PG8_SB(1, 1), b3 + hstep, voffB); PG8_STAGE(PG8_SA(1, 0), a3, o2[0]);
            PG8_WAIT_V(8); PG8_WAIT_L(0); PG8_BAR; PG8_MMA(1, 0, At, B0); PG8_MMA(1, 1, At, B1); PG8_BAR; PG8_SCHED;
        }
        if constexpr (FP8) PG8_F8_DRAIN;
        if (wr == 0) PG8_BAR;
        E(acc, cur, wr, wc, fr, fq, (const LAS float*)(lds + SCAL_OFF + sl_cur * 1024));
        if (!has_next) break;
#pragma unroll
        for (int a = 0; a < 2; ++a)
#pragma unroll
            for (int b = 0; b < 2; ++b)
#pragma unroll
                for (int m = 0; m < 4; ++m)
#pragma unroll
                    for (int n = 0; n < 2; ++n) acc[a][b][m][n] = (f32x4){0.f, 0.f, 0.f, 0.f};
        cur = nxt; cB = nB; ++ui; sl_cur = sl_nxt;
#pragma unroll
        for (int h = 0; h < 2; ++h)
#pragma unroll
            for (int i = 0; i < 2; ++i) oc[h][i] = on[h][i];
        if (wr == 1) PG8_BAR;
    }
    PG8_WAIT_V(0);
    PG8_BAR;
#undef PG8_SA
#undef PG8_SB
#undef PG8_STAGE
#undef PG8_LDA
#undef PG8_LDA_BF
#undef PG8_LDA_F8
#undef PG8_LDB_BF
#undef PG8_LDB_F8
#undef PG8_MMA_BF
#undef PG8_MMA_F8
#undef PG8_F8_DRAIN
#undef PG8_LDB
#undef PG8_MMA
#undef PG8_WAIT_V
#undef PG8_WAIT_L
#undef PG8_BAR
#undef PG8_SCHED
}

struct EpiProj {
    bf16* O; const float* rs;
    __device__ __forceinline__ void pre(const Unit& u, LAS unsigned char* slot, int wid, int lane) const {
        if (wid < 4) __builtin_amdgcn_global_load_lds((const unsigned*)(rs + u.pm * BM + wid * 64 + lane), (LAS unsigned*)(slot + wid * 256), 4, 0, 0);
    }
    __device__ __forceinline__ void operator()(const f32x4 (&acc)[2][2][4][2], const Unit& u, int wr, int wc, int fr, int fq, const LAS float* scal) const {
        const int row0 = u.pm * BM + wr * 64 + fr, col0 = u.pn * BM + wc * 32 + 8 * fq;
        float sc[2][4];
#pragma unroll
        for (int ai = 0; ai < 2; ++ai)
#pragma unroll
            for (int m = 0; m < 4; ++m) sc[ai][m] = scal[ai * HALF + wr * 64 + m * 16 + fr];
        if (u.pn >= 5) {
#pragma unroll
            for (int ai = 0; ai < 2; ++ai)
#pragma unroll
                for (int m = 0; m < 4; ++m) { const int row = row0 + ai * HALF + m * 16; const float s2 = sc[ai][m] * sc[ai][m];
                    const f32x4 v0 = acc[ai][0][m][0] * acc[ai][1][m][0] * s2, v1 = acc[ai][0][m][1] * acc[ai][1][m][1] * s2;
                    u32x4 w; w.x = pk2(v0[0], v0[1]); w.y = pk2(v0[2], v0[3]); w.z = pk2(v1[0], v1[1]); w.w = pk2(v1[2], v1[3]);
                    *(u32x4*)(O + (size_t)row * NPROJ + COL_U + (u.pn - 5) * 128 + wc * 32 + 8 * fq) = w; }
            return;
        }
#pragma unroll
        for (int ai = 0; ai < 2; ++ai)
#pragma unroll
            for (int m = 0; m < 4; ++m) { const int row = row0 + ai * HALF + m * 16; const float s = sc[ai][m]; bf16* rowp = O + (size_t)row * NPROJ + col0;
#pragma unroll
                for (int bj = 0; bj < 2; ++bj) { const f32x4 v0 = acc[ai][bj][m][0] * s, v1 = acc[ai][bj][m][1] * s;
                    u32x4 w; w.x = pk2(v0[0], v0[1]); w.y = pk2(v0[2], v0[3]); w.z = pk2(v1[0], v1[1]); w.w = pk2(v1[2], v1[3]);
                    *(u32x4*)(rowp + bj * HALF) = w; } }
    }
};
struct EpiOut {
    const bf16* xb; bf16* hb; unsigned char* hb8;
    __device__ __forceinline__ void pre(const Unit&, LAS unsigned char*, int, int) const {}
    __device__ __forceinline__ void operator()(const f32x4 (&acc)[2][2][4][2], const Unit& u, int wr, int wc, int fr, int fq, const LAS float*) const {
        const int row0 = u.pm * BM + wr * 64 + fr, col0 = u.pn * BM + wc * 32 + 8 * fq;
        u32x4 xr[2][4][2];
#pragma unroll
        for (int ai = 0; ai < 2; ++ai)
#pragma unroll
            for (int m = 0; m < 4; ++m) { const size_t off = (size_t)(row0 + ai * HALF + m * 16) * D + col0;
#pragma unroll
                for (int bj = 0; bj < 2; ++bj) xr[ai][m][bj] = *(const u32x4*)(xb + off + bj * HALF); }
#pragma unroll
        for (int ai = 0; ai < 2; ++ai)
#pragma unroll
            for (int m = 0; m < 4; ++m) { const size_t off = (size_t)(row0 + ai * HALF + m * 16) * D + col0;
#pragma unroll
                for (int bj = 0; bj < 2; ++bj) { const u32x4 xw = xr[ai][m][bj]; const f32x4 a0 = acc[ai][bj][m][0], a1 = acc[ai][bj][m][1];
                    const float h0 = bflo(xw.x) + a0[0], h1 = bfhi(xw.x) + a0[1], h2 = bflo(xw.y) + a0[2], h3 = bfhi(xw.y) + a0[3];
                    const float h4 = bflo(xw.z) + a1[0], h5 = bfhi(xw.z) + a1[1], h6 = bflo(xw.w) + a1[2], h7 = bfhi(xw.w) + a1[3];
                    u32x4 w; w.x = pk2(h0, h1); w.y = pk2(h2, h3); w.z = pk2(h4, h5); w.w = pk2(h6, h7);
                    *(u32x4*)(hb + off + bj * HALF) = w;
                    u32x2 w8; w8.x = pk4_fp8(h0, h1, h2, h3); w8.y = pk4_fp8(h4, h5, h6, h7);
                    *(u32x2*)(hb8 + off + bj * HALF) = w8; } }
    }
};
__device__ __forceinline__ float silu_mul(float g, float u) { return g * __builtin_amdgcn_rcpf(1.0f + __builtin_amdgcn_exp2f(-g * LOG2E)) * u; }
struct EpiSwiglu {
    unsigned char* hid; const float* rowrs;
    __device__ __forceinline__ void pre(const Unit& u, LAS unsigned char* slot, int wid, int lane) const {
        if (wid < 4) __builtin_amdgcn_global_load_lds((const unsigned*)(rowrs + (size_t)(u.pn >> 2) * ECAP + u.xa + wid * 64 + lane), (LAS unsigned*)(slot + wid * 256), 4, 0, 0);
    }
    __device__ __forceinline__ void operator()(const f32x4 (&acc)[2][2][4][2], const Unit& u, int wr, int wc, int fr, int fq, const LAS float* scal) const {
        const int j = u.pn & 3;
        float sc[2][4];
#pragma unroll
        for (int ai = 0; ai < 2; ++ai)
#pragma unroll
            for (int m = 0; m < 4; ++m) { const int rl = ai * HALF + wr * 64 + m * 16 + fr; sc[ai][m] = (u.xa + rl < u.xb) ? scal[rl] * W8_INV : 0.f; }
#pragma unroll
        for (int ai = 0; ai < 2; ++ai)
#pragma unroll
            for (int m = 0; m < 4; ++m) { const int rl = ai * HALF + wr * 64 + m * 16 + fr; const float s = sc[ai][m];
                const f32x4 g0 = acc[ai][0][m][0] * s, g1 = acc[ai][0][m][1] * s, u0 = acc[ai][1][m][0] * s, u1 = acc[ai][1][m][1] * s;
                u32x2 w; w.x = pk4_fp8(silu_mul(g0[0], u0[0]), silu_mul(g0[1], u0[1]), silu_mul(g0[2], u0[2]), silu_mul(g0[3], u0[3]));
                w.y = pk4_fp8(silu_mul(g1[0], u1[0]), silu_mul(g1[1], u1[1]), silu_mul(g1[2], u1[2]), silu_mul(g1[3], u1[3]));
                *(u32x2*)(hid + (size_t)(u.pm * BM + rl) * DEXP + j * 128 + wc * 32 + 8 * fq) = w; }
    }
};
struct EpiDown {
    unsigned char* y; const float* rowgate;
    __device__ __forceinline__ void pre(const Unit& u, LAS unsigned char* slot, int wid, int lane) const {
        if (wid < 4) __builtin_amdgcn_global_load_lds((const unsigned*)(rowgate + (size_t)(u.pn >> 2) * ECAP + u.xa + wid * 64 + lane), (LAS unsigned*)(slot + wid * 256), 4, 0, 0);
    }
    __device__ __forceinline__ void operator()(const f32x4 (&acc)[2][2][4][2], const Unit& u, int wr, int wc, int fr, int fq, const LAS float* scal) const {
        const int j = u.pn & 3;
        float sc[2][4];
#pragma unroll
        for (int ai = 0; ai < 2; ++ai)
#pragma unroll
            for (int m = 0; m < 4; ++m) { const int rl = ai * HALF + wr * 64 + m * 16 + fr; sc[ai][m] = (u.xa + rl < u.xb) ? scal[rl] * (W8_INV * Y8_SCALE) : 0.f; }
#pragma unroll
        for (int ai = 0; ai < 2; ++ai)
#pragma unroll
            for (int m = 0; m < 4; ++m) { const int rl = ai * HALF + wr * 64 + m * 16 + fr; const float s = sc[ai][m];
                unsigned char* rowp = y + (size_t)(u.pm * BM + rl) * D + j * BM + wc * 32 + 8 * fq;
#pragma unroll
                for (int bj = 0; bj < 2; ++bj) { const f32x4 v0 = acc[ai][bj][m][0] * s, v1 = acc[ai][bj][m][1] * s;
                    u32x2 w; w.x = pk4_fp8(v0[0], v0[1], v0[2], v0[3]); w.y = pk4_fp8(v1[0], v1[1], v1[2], v1[3]);
                    *(u32x2*)(rowp + bj * HALF) = w; } }
    }
};
}

struct Args {
    const float* x; const float* meta; const float* rel_bias; const float* mix_g; const float* w_in; const float* q_g; const float* k_g; const float* sinks;
    const float* conv_w; const float* ga; const float* gc; const float* w_out; const float* ffn_g; const float* w_gr; const float* b_gr; const float* w_er; const float* b_er;
    const float* w_gate; const float* w_up; const float* w_down;
    float* out; unsigned char* ws;
};

struct TrRegs { f32x4 v[2][8]; float sk[8]; };
template <bool SCALE>
__device__ __forceinline__ void tr_load(TrRegs& t, const float* W, int ldw, const float* ks, int k0, int n0, int lane) {
    const int q = lane & 7, kg = lane >> 3;
    const float* src = W + (size_t)(k0 + 8 * kg) * ldw + n0 + 4 * q;
#pragma unroll
    for (int hh = 0; hh < 2; ++hh)
#pragma unroll
        for (int i = 0; i < 8; ++i) t.v[hh][i] = __builtin_nontemporal_load((const f32x4*)(src + (size_t)i * ldw + 32 * hh));
    if (SCALE) { const f32x4 s0 = *(const f32x4*)(ks + k0 + 8 * kg), s1 = *(const f32x4*)(ks + k0 + 8 * kg + 4);
#pragma unroll
        for (int i = 0; i < 4; ++i) { t.sk[i] = s0[i]; t.sk[4 + i] = s1[i]; } }
    else {
#pragma unroll
        for (int i = 0; i < 8; ++i) t.sk[i] = 1.f; }
}
__device__ __forceinline__ void tr_store(const TrRegs& t, bf16* WT, int ldt, int k0, int drow0, int lane) {
    const int q = lane & 7, kg = lane >> 3;
#pragma unroll
    for (int hh = 0; hh < 2; ++hh)
#pragma unroll
        for (int ni = 0; ni < 4; ++ni) {
            u32x4 o; o.x = pk2(t.v[hh][0][ni] * t.sk[0], t.v[hh][1][ni] * t.sk[1]); o.y = pk2(t.v[hh][2][ni] * t.sk[2], t.v[hh][3][ni] * t.sk[3]);
            o.z = pk2(t.v[hh][4][ni] * t.sk[4], t.v[hh][5][ni] * t.sk[5]); o.w = pk2(t.v[hh][6][ni] * t.sk[6], t.v[hh][7][ni] * t.sk[7]);
            *(u32x4*)(WT + (size_t)(drow0 + 32 * hh + 4 * q + ni) * ldt + k0 + 8 * kg) = o; }
}
template <bool SCALE>
__device__ __forceinline__ void tr_item(const float* W, int ldw, const float* ks, bf16* WT, int ldt, int k0, int n0, int drow0, int lane) {
    TrRegs t; tr_load<SCALE>(t, W, ldw, ks, k0, n0, lane); tr_store(t, WT, ldt, k0, drow0, lane);
}

struct TrItem { f32x4 v[16]; float sk[16]; };
__device__ __forceinline__ void conv_item_load(TrItem& t, const Args& a, int pool, int it, int lane) {
    const int q = lane & 7, kg = lane >> 3;
    const float* W; int ldw, k0, n0;
    if (pool == 0) { int r = it; const int up = r >= 4096 ? 1 : 0; if (up) r -= 4096; const int e = r >> 7, qq = r & 127; k0 = 128 * (qq >> 4); n0 = 32 * (qq & 15); W = (up ? a.w_up : a.w_gate) + (size_t)e * D * DEXP; ldw = DEXP; }
    else { const int e = it >> 7, qq = it & 127; k0 = 128 * (qq >> 5); n0 = 32 * (qq & 31); W = a.w_down + (size_t)e * DEXP * D; ldw = D; }
    const float* src = W + (size_t)(k0 + 16 * kg) * ldw + n0 + 4 * q;
#pragma unroll
    for (int i = 0; i < 16; ++i) t.v[i] = *(const f32x4*)(src + (size_t)i * ldw);
    if (pool == 0) {
#pragma unroll
        for (int i4 = 0; i4 < 4; ++i4) { const f32x4 sv = *(const f32x4*)(a.ffn_g + k0 + 16 * kg + 4 * i4);
#pragma unroll
            for (int i = 0; i < 4; ++i) t.sk[4 * i4 + i] = sv[i] * W8_SCALE; }
    } else {
#pragma unroll
        for (int i = 0; i < 16; ++i) t.sk[i] = W8_SCALE;
    }
}
__device__ __forceinline__ void conv_item_store(const TrItem& t, const Args& a, int pool, int it, int lane) {
    const int q = lane & 7, kg = lane >> 3;
    unsigned char* WT; int ldt, k0, drow0;
    if (pool == 0) { int r = it; const int up = r >= 4096 ? 1 : 0; if (up) r -= 4096; const int e = r >> 7, qq = r & 127, n0 = 32 * (qq & 15); k0 = 128 * (qq >> 4);
        WT = a.ws + WS_WGU; ldt = D; drow0 = e * 1024 + (n0 >> 7) * 256 + up * 128 + (n0 & 127); }
    else { const int e = it >> 7, qq = it & 127; k0 = 128 * (qq >> 5); WT = a.ws + WS_WD; ldt = DEXP; drow0 = e * 1024 + 32 * (qq & 31); }
#pragma unroll
    for (int ni = 0; ni < 4; ++ni) {
        u32x4 o;
        o.x = pk4_fp8(t.v[0][ni] * t.sk[0], t.v[1][ni] * t.sk[1], t.v[2][ni] * t.sk[2], t.v[3][ni] * t.sk[3]);
        o.y = pk4_fp8(t.v[4][ni] * t.sk[4], t.v[5][ni] * t.sk[5], t.v[6][ni] * t.sk[6], t.v[7][ni] * t.sk[7]);
        o.z = pk4_fp8(t.v[8][ni] * t.sk[8], t.v[9][ni] * t.sk[9], t.v[10][ni] * t.sk[10], t.v[11][ni] * t.sk[11]);
        o.w = pk4_fp8(t.v[12][ni] * t.sk[12], t.v[13][ni] * t.sk[13], t.v[14][ni] * t.sk[14], t.v[15][ni] * t.sk[15]);
        *(u32x4*)(WT + (size_t)(drow0 + 4 * q + ni) * ldt + k0 + 16 * kg) = o; }
}
__device__ __forceinline__ void conv_pool(const Args& a, int pool, int rank, int nranks, int total) {
    const int lane = threadIdx.x & 63, wave = threadIdx.x >> 6;
    const int gwv = rank * 8 + wave, NW = nranks * 8;
    if (gwv >= total) return;
    const int n = (total - gwv + NW - 1) / NW;
    const int last = gwv + (n - 1) * NW;
    TrItem r0, r1;
    conv_item_load(r0, a, pool, min(gwv, last), lane); conv_item_load(r1, a, pool, min(gwv + NW, last), lane);
    for (int j = 0; j < n; j += 2) {
        const int b0 = gwv + j * NW;
        conv_item_store(r0, a, pool, min(b0, last), lane);      conv_item_load(r0, a, pool, min(b0 + 2 * NW, last), lane);
        conv_item_store(r1, a, pool, min(b0 + NW, last), lane); conv_item_load(r1, a, pool, min(b0 + 3 * NW, last), lane);
    }
}
__device__ __forceinline__ int conv_slot(int nunits, int G, int c) {
    const int rem = nunits % G;
    if (rem == 0) return -2;
    if (c < rem) return -1;
    const int nmine = nunits / G;
    return (c - rem) % (nmine + 1);
}
__device__ __forceinline__ void conv_mine(const Args& a, int pool, int nunits, int G, int c, int total) {
    const int rem = nunits % G;
    if (rem == 0) conv_pool(a, pool, c, G, total); else conv_pool(a, pool, c - rem, G - rem, total);
}
__device__ __forceinline__ void conv_dyn(const Args& a, int pool, int lo, int hi, LAS unsigned char* lds, unsigned* q) {
    const int lane = threadIdx.x & 63, wave = threadIdx.x >> 6;
    volatile LAS int* tk = (volatile LAS int*)(lds + LDSCTL_OFF + 640);
    for (;;) {
        __syncthreads();
        if (threadIdx.x == 0) *tk = (int)__hip_atomic_fetch_add(q, 1u, __ATOMIC_RELAXED, __HIP_MEMORY_SCOPE_AGENT);
        __syncthreads();
        const int base = lo + (*tk) * 8;
        if (base >= hi) break;
        const int it = base + wave;
        if (it < hi) { TrItem r; conv_item_load(r, a, pool, it, lane); conv_item_store(r, a, pool, it, lane); }
    }
}

__device__ __forceinline__ void p0_prologue(const Args& a, LAS unsigned char* lds, int G) {
    const int tid = threadIdx.x, lane = tid & 63, wave = tid >> 6;
    unsigned char* ws = a.ws;
    const int gw = blockIdx.x * 8 + wave, NGW = G * 8;
    bf16* Win = (bf16*)(ws + WS_WIN); bf16* Wout = (bf16*)(ws + WS_WOUT);
    constexpr int I_IN = 16 * 36, I_OUT = 16 * 16;
    constexpr int NITEMS = I_IN + I_OUT;
    for (int it = gw; it < NITEMS; it += NGW) {
        int r = it;
        if (r < I_IN) { const int kb = r / 36, nb = r % 36, n0 = 64 * nb;
            int drow = n0;
            if (n0 >= 1792) { const int c = n0 - 1792; drow = 1280 + (c >> 7) * 256 + 128 + (c & 127); } else if (n0 >= 1280) { const int c = n0 - 1280; drow = 1280 + (c >> 7) * 256 + (c & 127); }
            tr_item<true>(a.w_in, NPROJ, a.mix_g, Win, D, 64 * kb, n0, drow, lane); continue; } r -= I_IN;
        { const int kb = r >> 4, nb = r & 15; const int k0 = 64 * kb; const float* ks = k0 < 512 ? a.ga : a.gc - 512;
            tr_item<true>(a.w_out, D, ks, Wout, D, k0, 64 * nb, 64 * nb, lane); }
    }
    bf16* Wr = (bf16*)(ws + WS_WR);
    for (int idx = blockIdx.x * 512 + tid; idx < 48 * 1024; idx += G * 512) { const int c = idx >> 10, k = idx & 1023;
        float v = 0.f; if (c < 4) v = a.w_gr[k * 4 + c]; else if (c < 36) v = a.w_er[k * 32 + (c - 4)];
        Wr[idx] = (bf16)(pk2(v * a.ffn_g[k], 0.f) & 0xffffu); }
    bf16* XB = (bf16*)(ws + WS_XB); float* rsx = (float*)(ws + WS_RSX);
    for (int m0 = 2 * gw; m0 < MROWS; m0 += 2 * NGW) {
        f32x4 v[2][4];
#pragma unroll
        for (int rr = 0; rr < 2; ++rr) { const int m = m0 + rr;
            if (m < MTOK + NMETA) { const float* src = m < MTOK ? a.x + (size_t)m * D : a.meta + (size_t)(m - MTOK) * D;
#pragma unroll
                for (int j = 0; j < 4; ++j) v[rr][j] = __builtin_nontemporal_load((const f32x4*)(src + 4 * lane + 256 * j));
            } else {
#pragma unroll
                for (int j = 0; j < 4; ++j) v[rr][j] = (f32x4){0.f, 0.f, 0.f, 0.f};
            } }
#pragma unroll
        for (int rr = 0; rr < 2; ++rr) { const int m = m0 + rr;
            float s = 0.f;
#pragma unroll
            for (int j = 0; j < 4; ++j) s += (v[rr][j].x * v[rr][j].x + v[rr][j].y * v[rr][j].y) + (v[rr][j].z * v[rr][j].z + v[rr][j].w * v[rr][j].w);
            s = wave_sum(s);
            if (lane == 0) rsx[m] = (m < MTOK + NMETA) ? rsqrtf(s * (1.f / D) + EPS) : 0.f;
#pragma unroll
            for (int j = 0; j < 4; ++j) { u32x2 w; w.x = pk2(v[rr][j].x, v[rr][j].y); w.y = pk2(v[rr][j].z, v[rr][j].w); *(u32x2*)(XB + (size_t)m * D + 4 * lane + 256 * j) = w; } }
    }
}

__device__ __forceinline__ int t5_bucket(int n) {
    if (n < 16) return n;
    const float v = logf((float)n * 0.0625f) * (16.0f / 2.0794415416798357f);
    int l = 16 + (int)v; return l < 31 ? l : 31;
}
__device__ __forceinline__ int crow(int r, int hi) { return (r & 3) + 8 * (r >> 2) + 4 * hi; }

__device__ __forceinline__ void p2_attn_conv(const Args& a, LAS unsigned char* lds, int G) {
    const int tid = threadIdx.x, lane = tid & 63, wave = __builtin_amdgcn_readfirstlane(tid >> 6);
    const bf16* PROJ = (const bf16*)(a.ws + WS_PROJ); bf16* MIXED = (bf16*)(a.ws + WS_MIXED);
    LAS float* biasT = (LAS float*)(lds + BIAS_OFF); LAS float* ssA = (LAS float*)(lds + SSA_OFF); LAS float* bndH = (LAS float*)(lds + SSA_OFF + 4096);
    for (int unit = blockIdx.x; unit < NB * 64; unit += G) {
        const int b = unit >> 6, blk = unit & 63;
        __syncthreads();
        u32x4 qraw[4];
        {
            const size_t qrow0 = (size_t)(b * SEQ + blk * 128 + (lane & 31));
#pragma unroll
            for (int s4 = 0; s4 < 4; ++s4) qraw[s4] = __builtin_nontemporal_load((const u32x4*)(PROJ + qrow0 * NPROJ + wave * 64 + 16 * s4 + 8 * (lane >> 5)));
        }
        const f32x4 gk0 = *(const f32x4*)(a.k_g + (tid & 7) * 8), gk1 = *(const f32x4*)(a.k_g + (tid & 7) * 8 + 4);
        const f32x4 gq0 = *(const f32x4*)(a.q_g + (tid & 7) * 8), gq1 = *(const f32x4*)(a.q_g + (tid & 7) * 8 + 4);
        const f32x4 gs0 = gk0 * gq0 * (0.125f * LOG2E), gs1 = gk1 * gq1 * (0.125f * LOG2E);
        float ggm;
        { const f32x4 p0 = gk0 * gq0, p1 = gk1 * gq1;
          ggm = fmaxf(fmaxf(fmaxf(fabsf(p0[0]), fabsf(p0[1])), fmaxf(fabsf(p0[2]), fabsf(p0[3]))), fmaxf(fmaxf(fabsf(p1[0]), fabsf(p1[1])), fmaxf(fabsf(p1[2]), fabsf(p1[3]))));
          ggm = fmaxf(ggm, __shfl_xor(ggm, 1)); ggm = fmaxf(ggm, __shfl_xor(ggm, 2)); ggm = fmaxf(ggm, __shfl_xor(ggm, 4)); }
        if (tid < 8) { float bm = a.rel_bias[tid];
            for (int bkt = 1; bkt < 32; ++bkt) bm = fmaxf(bm, a.rel_bias[bkt * 8 + tid]);
            bndH[tid] = (8.0f * 1.02f * LOG2E) * ggm + LOG2E * bm; }
#pragma unroll 1
        for (int pass = 0; pass < 2; ++pass) {
            u32x4 kraw[4], vraw[4];
#pragma unroll
            for (int i4 = 0; i4 < 4; ++i4) {
                const int idx = (pass * 4 + i4) * 512 + tid; const int chunk = idx & 7, kvh = (idx >> 3) & 1, wk = idx >> 4;
                const int tpos = blk * 128 - 128 + wk;
                const int row = tpos >= 0 ? b * SEQ + tpos : MTOK + NMETA + tpos;
                kraw[i4] = (u32x4){0u, 0u, 0u, 0u}; vraw[i4] = (u32x4){0u, 0u, 0u, 0u};
                if (tpos >= -NMETA) { const bf16* p = PROJ + (size_t)row * NPROJ + kvh * 64 + chunk * 8; kraw[i4] = *(const u32x4*)(p + COL_K); vraw[i4] = *(const u32x4*)(p + COL_V); }
            }
#pragma unroll
            for (int i4 = 0; i4 < 4; ++i4) {
                const int idx = (pass * 4 + i4) * 512 + tid; const int chunk = idx & 7, kvh = (idx >> 3) & 1, wk = idx >> 4;
                float kf[8];
#pragma unroll
                for (int j = 0; j < 4; ++j) { kf[2 * j] = bflo(kraw[i4][j]); kf[2 * j + 1] = bfhi(kraw[i4][j]); }
                float ss = 0.f;
#pragma unroll
                for (int j = 0; j < 8; ++j) ss += kf[j] * kf[j];
                ss += __shfl_xor(ss, 1); ss += __shfl_xor(ss, 2); ss += __shfl_xor(ss, 4);
                const float sc = rsqrtf(ss * (1.f / 64.f) + EPS);
                u32x4 kw;
                kw.x = pk2(kf[0] * sc * gs0[0], kf[1] * sc * gs0[1]); kw.y = pk2(kf[2] * sc * gs0[2], kf[3] * sc * gs0[3]);
                kw.z = pk2(kf[4] * sc * gs1[0], kf[5] * sc * gs1[1]); kw.w = pk2(kf[6] * sc * gs1[2], kf[7] * sc * gs1[3]);
                *(LAS u32x4*)(lds + KN_OFF + kvh * KN_HEAD + wk * 128 + ((chunk ^ (wk & 7)) << 4)) = kw;
                const int slot = ((wk & ~12) | ((wk & 4) << 1) | ((wk & 8) >> 1)) ^ (chunk << 3);
                LAS unsigned char* vt = lds + VT_OFF + kvh * VT_HEAD + (chunk * 8) * VT_ROW + slot * 2;
#pragma unroll
                for (int j = 0; j < 8; ++j) *(LAS unsigned short*)(vt + j * VT_ROW) = (unsigned short)(vraw[i4][j >> 1] >> (16 * (j & 1)));
            }
        }
        __syncthreads();
        for (int e2 = tid; e2 < 8 * 192; e2 += 512) { const int h = e2 / 192, dist = e2 % 192 - 31; biasT[e2] = (dist >= 0 && dist < 128) ? a.rel_bias[t5_bucket(dist) * 8 + h] * LOG2E - bndH[h] : -1e30f; }
        __syncthreads();
        {
            const int h = wave, kvh = wave >> 2, r = lane & 31, hi = lane >> 5;
            const LAS unsigned char* KnB = lds + KN_OFF + kvh * KN_HEAD; const LAS unsigned char* VTB = lds + VT_OFF + kvh * VT_HEAD;
            const float sink = a.sinks[h] * LOG2E - bndH[h];
            const int wkmin = (blk == 0) ? (128 - NMETA) : 0;
            for (int qi = 0; qi < 4; ++qi) {
                const size_t qrow = (size_t)(b * SEQ + blk * 128 + 32 * qi + r);
                float ss = 0.f;
#pragma unroll
                for (int s = 0; s < 4; ++s)
#pragma unroll
                    for (int j = 0; j < 4; ++j) { const float lo = bflo(qraw[s][j]), hh = bfhi(qraw[s][j]); ss += lo * lo + hh * hh; }
                ss += __shfl_xor(ss, 32);
                const float qsc = rsqrtf(ss * (1.f / 64.f) + EPS);
                bf16x8 qf[4];
#pragma unroll
                for (int s = 0; s < 4; ++s) { u32x4 w;
#pragma unroll
                    for (int j = 0; j < 4; ++j) w[j] = pk2(bflo(qraw[s][j]) * qsc, bfhi(qraw[s][j]) * qsc);
                    qf[s] = __builtin_bit_cast(bf16x8, w); }
                if (qi < 3) {
#pragma unroll
                    for (int s = 0; s < 4; ++s) qraw[s] = __builtin_nontemporal_load((const u32x4*)(PROJ + (qrow + 32) * NPROJ + h * 64 + 16 * s + 8 * hi));
                }
                const LAS float* bt = biasT + h * 192 + 31 + 128 + r - 4 * hi;
                f32x16 S[5];
#pragma unroll
                for (int k5 = 0; k5 < 5; ++k5) {
                    const int key = 32 * (qi + k5) + r;
                    f32x16 accs;
#pragma unroll
                    for (int i = 0; i < 16; ++i) accs[i] = bt[-32 * k5 - ((i & 3) + 8 * (i >> 2))];
#pragma unroll
                    for (int s = 0; s < 4; ++s) { const bf16x8 kfr = *(const LAS bf16x8*)(KnB + key * 128 + (((2 * s + hi) ^ (key & 7)) << 4));
                        accs = __builtin_amdgcn_mfma_f32_32x32x16_bf16(kfr, qf[s], accs, 0, 0, 0); }
                    S[k5] = accs;
                }
                if (blk == 0) {
#pragma unroll
                    for (int k5 = 0; k5 < 5; ++k5)
#pragma unroll
                        for (int i = 0; i < 16; ++i) if (32 * (qi + k5) + crow(i, hi) < wkmin) S[k5][i] = -1e30f;
                }
                float l = 0.f;
#pragma unroll
                for (int k5 = 0; k5 < 5; ++k5)
#pragma unroll
                    for (int i = 0; i < 16; ++i) { const float p = __builtin_amdgcn_exp2f(S[k5][i]); S[k5][i] = p; l += p; }
                l += __shfl_xor(l, 32);
                l += __builtin_amdgcn_exp2f(sink);
                f32x16 O0, O1;
#pragma unroll
                for (int i = 0; i < 16; ++i) { O0[i] = 0.f; O1[i] = 0.f; }
#pragma unroll
                for (int k5 = 0; k5 < 5; ++k5)
#pragma unroll
                    for (int s2 = 0; s2 < 2; ++s2) {
                        u32x4 pw;
#pragma unroll
                        for (int j = 0; j < 4; ++j) pw[j] = pk2(S[k5][8 * s2 + 2 * j], S[k5][8 * s2 + 2 * j + 1]);
                        const bf16x8 pf = __builtin_bit_cast(bf16x8, pw);
                        const int sl = 32 * (qi + k5) + 16 * s2 + 8 * hi;
                        const bf16x8 v0 = *(const LAS bf16x8*)(VTB + r * VT_ROW + ((sl ^ ((r >> 3) << 3)) << 1)), v1 = *(const LAS bf16x8*)(VTB + (32 + r) * VT_ROW + ((sl ^ ((4 + (r >> 3)) << 3)) << 1));
                        O0 = __builtin_amdgcn_mfma_f32_32x32x16_bf16(v0, pf, O0, 0, 0, 0);
                        O1 = __builtin_amdgcn_mfma_f32_32x32x16_bf16(v1, pf, O1, 0, 0, 0);
                    }
                const float inv = 1.0f / l;
                float so = 0.f;
#pragma unroll
                for (int i = 0; i < 16; ++i) { O0[i] *= inv; O1[i] *= inv; so += O0[i] * O0[i] + O1[i] * O1[i]; }
                so += __shfl_xor(so, 32);
                if (hi == 0) ssA[qi * 256 + r * 8 + h] = so;
                __syncthreads();
                float tot = 0.f;
#pragma unroll
                for (int hh = 0; hh < 8; ++hh) tot += ssA[qi * 256 + r * 8 + hh];
                const float rsa = rsqrtf(tot * (1.f / 512.f) + EPS);
                bf16* orow = MIXED + qrow * D + h * 64 + 4 * hi;
#pragma unroll
                for (int g4 = 0; g4 < 4; ++g4) {
                    u32x2 w0; w0.x = pk2(O0[4 * g4] * rsa, O0[4 * g4 + 1] * rsa); w0.y = pk2(O0[4 * g4 + 2] * rsa, O0[4 * g4 + 3] * rsa);
                    u32x2 w1; w1.x = pk2(O1[4 * g4] * rsa, O1[4 * g4 + 1] * rsa); w1.y = pk2(O1[4 * g4 + 2] * rsa, O1[4 * g4 + 3] * rsa);
                    *(u32x2*)(orow + 8 * g4) = w0; *(u32x2*)(orow + 32 + 8 * g4) = w1;
                }
            }
        }
        {
            const int c0 = 8 * lane;
            float cw[3][8];
#pragma unroll
            for (int j = 0; j < 3; ++j) { const f32x4 w0 = *(const f32x4*)(a.conv_w + j * 512 + c0), w1 = *(const f32x4*)(a.conv_w + j * 512 + c0 + 4);
#pragma unroll
                for (int i = 0; i < 4; ++i) { cw[j][i] = w0[i]; cw[j][4 + i] = w1[i]; } }
            const int tbase = blk * 128 + wave * 16;
            float u2[8], u1[8];
            {
                u32x4 hu[2];
#pragma unroll
                for (int i = 0; i < 2; ++i) { const int tpos = tbase - 2 + i; const size_t row = tpos >= 0 ? (size_t)(b * SEQ + tpos) : (size_t)(MTOK + NMETA + tpos);
                    hu[i] = *(const u32x4*)(PROJ + row * NPROJ + COL_U + c0); }
#pragma unroll
                for (int j = 0; j < 4; ++j) { u2[2 * j] = bflo(hu[0][j]); u2[2 * j + 1] = bfhi(hu[0][j]); u1[2 * j] = bflo(hu[1][j]); u1[2 * j + 1] = bfhi(hu[1][j]); }
            }
            u32x4 rb[4], ru[4];
#pragma unroll
            for (int i = 0; i < 4; ++i) { const bf16* p = PROJ + (size_t)(b * SEQ + tbase + i) * NPROJ + c0; rb[i] = __builtin_nontemporal_load((const u32x4*)(p + COL_CB)); ru[i] = __builtin_nontemporal_load((const u32x4*)(p + COL_U)); }
#pragma unroll
            for (int g = 0; g < 4; ++g) {
                u32x4 nb[4], nu[4];
                if (g < 3) {
#pragma unroll
                    for (int i = 0; i < 4; ++i) { const bf16* p = PROJ + (size_t)(b * SEQ + tbase + 4 * g + 4 + i) * NPROJ + c0; nb[i] = __builtin_nontemporal_load((const u32x4*)(p + COL_CB)); nu[i] = __builtin_nontemporal_load((const u32x4*)(p + COL_U)); }
                }
                float cv[4][8], ssq[4];
#pragma unroll
                for (int i = 0; i < 4; ++i) {
                    float u0[8];
#pragma unroll
                    for (int j = 0; j < 4; ++j) { u0[2 * j] = bflo(ru[i][j]); u0[2 * j + 1] = bfhi(ru[i][j]); }
                    float ss = 0.f;
#pragma unroll
                    for (int j = 0; j < 4; ++j) {
                        const float y0 = cw[0][2 * j] * u2[2 * j] + cw[1][2 * j] * u1[2 * j] + cw[2][2 * j] * u0[2 * j];
                        const float y1 = cw[0][2 * j + 1] * u2[2 * j + 1] + cw[1][2 * j + 1] * u1[2 * j + 1] + cw[2][2 * j + 1] * u0[2 * j + 1];
                        cv[i][2 * j] = bflo(rb[i][j]) * y0; cv[i][2 * j + 1] = bfhi(rb[i][j]) * y1; ss += cv[i][2 * j] * cv[i][2 * j] + cv[i][2 * j + 1] * cv[i][2 * j + 1]; }
                    ssq[i] = ss;
#pragma unroll
                    for (int j = 0; j < 8; ++j) { u2[j] = u1[j]; u1[j] = u0[j]; }
                }
#pragma unroll
                for (int o = 1; o < 64; o <<= 1) {
#pragma unroll
                    for (int i = 0; i < 4; ++i) ssq[i] += __shfl_xor(ssq[i], o); }
#pragma unroll
                for (int i = 0; i < 4; ++i) {
                    const float rcs = rsqrtf(ssq[i] * (1.f / 512.f) + EPS);
                    u32x4 w; w.x = pk2(cv[i][0] * rcs, cv[i][1] * rcs); w.y = pk2(cv[i][2] * rcs, cv[i][3] * rcs); w.z = pk2(cv[i][4] * rcs, cv[i][5] * rcs); w.w = pk2(cv[i][6] * rcs, cv[i][7] * rcs);
                    *(u32x4*)(MIXED + (size_t)(b * SEQ + tbase + 4 * g + i) * D + 512 + c0) = w; }
                if (g < 3) {
#pragma unroll
                    for (int i = 0; i < 4; ++i) { rb[i] = nb[i]; ru[i] = nu[i]; }
                }
            }
        }
    }
}

__device__ __forceinline__ void p4_router(const Args& a, LAS unsigned char* lds, int G) {
    const int tid = threadIdx.x, lane = tid & 63, wave = __builtin_amdgcn_readfirstlane(tid >> 6);
    const bf16* HB = (const bf16*)(a.ws + WS_HB); const bf16* Wr = (const bf16*)(a.ws + WS_WR);
    int* rowtok = (int*)(a.ws + WS_ROWTOK); float* rowrs = (float*)(a.ws + WS_ROWRS); float* rowgate = (float*)(a.ws + WS_ROWGATE); int* tokslot = (int*)(a.ws + WS_TOKSLOT);
    unsigned* gcnt = (unsigned*)(a.ws + WS_CTL) + CW_CNT;
    LAS int* lcnt = (LAS int*)(lds + LDSCTL_OFF + MISC_LCNT); LAS int* lbase = (LAS int*)(lds + LDSCTL_OFF + MISC_LBASE);
    LAS float* lg = (LAS float*)(lds + 99328 + wave * 4096);
    constexpr int WR_ROW = 2064;
    __syncthreads();
#pragma unroll
    for (int i = 0; i < 12; ++i) { const int id = i * 512 + tid, row = id >> 7, cc = id & 127;
        *(LAS u32x4*)(lds + row * WR_ROW + cc * 16) = *(const u32x4*)(Wr + (size_t)row * D + cc * 8); }
    for (int chunk = blockIdx.x; chunk < MTOK / 128; chunk += G) {
        __syncthreads();
        if (tid < NEXP) lcnt[tid] = 0;
        __syncthreads();
        const int t0 = chunk * 128 + wave * 16, r16 = lane & 15, q4 = lane >> 4;
        f32x4 acc[3];
#pragma unroll
        for (int c = 0; c < 3; ++c) acc[c] = (f32x4){0.f, 0.f, 0.f, 0.f};
        float ss = 0.f;
        const bf16* arow = HB + (size_t)(t0 + r16) * D + 8 * q4;
        const LAS unsigned char* brow = lds + r16 * WR_ROW + q4 * 16;
        u32x4 aw[32];
#pragma unroll
        for (int ks = 0; ks < 32; ++ks) aw[ks] = *(const u32x4*)(arow + ks * 32);
#pragma unroll
        for (int ks = 0; ks < 32; ++ks) {
#pragma unroll
            for (int j = 0; j < 4; ++j) { const float lo = bflo(aw[ks][j]), hh = bfhi(aw[ks][j]); ss += lo * lo + hh * hh; }
            const bf16x8 af = __builtin_bit_cast(bf16x8, aw[ks]);
#pragma unroll
            for (int c = 0; c < 3; ++c) { const bf16x8 bfr = *(const LAS bf16x8*)(brow + c * 16 * WR_ROW + ks * 64); acc[c] = __builtin_amdgcn_mfma_f32_16x16x32_bf16(af, bfr, acc[c], 0, 0, 0); }
        }
        ss += __shfl_xor(ss, 16); ss += __shfl_xor(ss, 32);
#pragma unroll
        for (int c = 0; c < 3; ++c)
#pragma unroll
            for (int i = 0; i < 4; ++i) lg[(4 * q4 + i) * 49 + 16 * c + r16] = acc[c][i];
        LDS_WAIT(); __builtin_amdgcn_wave_barrier();
        int e1 = 0, e2 = 0, p1 = 0, p2 = 0; float g1 = 0.f, g2 = 0.f, rs = 0.f;
        if (lane < 16) {
            rs = rsqrtf(ss * (1.f / D) + EPS);
            const LAS float* my = lg + lane * 49;
            float gl[4];
#pragma unroll
            for (int c = 0; c < 4; ++c) gl[c] = my[c] * rs + a.b_gr[c];
            int gi = 0; float gm = gl[0];
#pragma unroll
            for (int c = 1; c < 4; ++c) if (gl[c] > gm) { gm = gl[c]; gi = c; }
            float gs = 0.f;
#pragma unroll
            for (int c = 0; c < 4; ++c) gs += __expf(gl[c] - gm);
            const float gp = 1.0f / gs;
            float el[8];
#pragma unroll
            for (int e = 0; e < 8; ++e) el[e] = my[4 + gi * 8 + e] * rs + a.b_er[gi * 8 + e];
            int i1 = 0; float v1 = el[0];
#pragma unroll
            for (int e = 1; e < 8; ++e) if (el[e] > v1) { v1 = el[e]; i1 = e; }
            int i2 = -1; float v2 = -3.0e38f;
#pragma unroll
            for (int e = 0; e < 8; ++e) if (e != i1 && el[e] > v2) { v2 = el[e]; i2 = e; }
            const float ex = __expf(v2 - v1); const float w1 = 1.0f / (1.0f + ex), w2 = ex * w1;
            e1 = gi * 8 + i1; e2 = gi * 8 + i2; g1 = gp * w1; g2 = gp * w2;
            p1 = __hip_atomic_fetch_add(lcnt + e1, 1, __ATOMIC_RELAXED, __HIP_MEMORY_SCOPE_WORKGROUP);
            p2 = __hip_atomic_fetch_add(lcnt + e2, 1, __ATOMIC_RELAXED, __HIP_MEMORY_SCOPE_WORKGROUP);
        }
        __syncthreads();
        if (tid < NEXP) { const int n = lcnt[tid]; int base = 0; if (n > 0) base = (int)__hip_atomic_fetch_add(gcnt + 64 * tid, (unsigned)n, __ATOMIC_RELAXED, __HIP_MEMORY_SCOPE_AGENT); lbase[tid] = base; }
        __syncthreads();
        if (lane < 16) {
            const int tok = t0 + lane;
            const int s1 = e1 * ECAP + lbase[e1] + p1, s2 = e2 * ECAP + lbase[e2] + p2;
            rowtok[s1] = tok; rowrs[s1] = rs; rowgate[s1] = g1;
            rowtok[s2] = tok; rowrs[s2] = rs; rowgate[s2] = g2;
            tokslot[2 * tok] = s1; tokslot[2 * tok + 1] = s2;
        }
    }
}

__device__ __forceinline__ int moe_tables(const Args& a, LAS unsigned char* lds) {
    LAS int* tstart = (LAS int*)(lds + LDSCTL_OFF + MISC_TSTART); LAS int* cnt = (LAS int*)(lds + LDSCTL_OFF + MISC_CNT);
    unsigned* gcnt = (unsigned*)(a.ws + WS_CTL) + CW_CNT;
    __syncthreads();
    if (threadIdx.x < 64) {
        const int lane = threadIdx.x;
        int c = 0; if (lane < NEXP) c = (int)__hip_atomic_load(gcnt + 64 * lane, __ATOMIC_RELAXED, __HIP_MEMORY_SCOPE_AGENT);
        const int tl = (c + 255) >> 8; int s = tl;
#pragma unroll
        for (int d = 1; d < NEXP; d <<= 1) { const int o = __shfl_up(s, d); if (lane >= d) s += o; }
        if (lane < NEXP) { cnt[lane] = c; tstart[lane] = s - tl; }
        if (lane == NEXP - 1) tstart[NEXP] = s;
    }
    __syncthreads();
    return tstart[NEXP];
}

#define PH(k, call) do { if (AMP_PHASE == (k)) amp_t0 = __builtin_amdgcn_s_memrealtime(); call; xcd_barrier(bar); if (AMP_PHASE == (k)) amp_t1 = __builtin_amdgcn_s_memrealtime(); if (REP_PHASE == (k)) { call; xcd_barrier(bar); } } while (0)
__device__ __forceinline__ void ph_inproj(const Args& a, LAS unsigned char* lds, int G, unsigned long long& amp_t0, unsigned long long& amp_t1) {
    unsigned char* ws = a.ws;
    pg8::Gemm g{(const bf16*)(ws + WS_XB), (const bf16*)(ws + WS_WIN), D};
    pg8::StaticOrder S; S.init(MROWS, NPROJ, D, G, (int)blockIdx.x);
    pg8::EpiProj E{(bf16*)(ws + WS_PROJ), (const float*)(ws + WS_RSX)};
    constexpr int NU = (MROWS / 256) * (NPROJ / 256);
    constexpr int GU_ITEMS = 8192, GU_STATIC = 5120;
    const int slot = conv_slot(NU, G, (int)blockIdx.x);
    if (slot >= 0) { S.i1 = slot; pg8::gemm_phase<false>(lds, g, S, E); conv_mine(a, 0, NU, G, (int)blockIdx.x, GU_STATIC); S.i0 = slot; S.i1 = 1 << 24; pg8::gemm_phase<false>(lds, g, S, E); }
    else { pg8::gemm_phase<false>(lds, g, S, E); if (slot == -2) conv_mine(a, 0, NU, G, (int)blockIdx.x, GU_STATIC); }
    conv_dyn(a, 0, GU_STATIC, GU_ITEMS, lds, (unsigned*)(ws + WS_CTL) + CW_Q);
}
__device__ __forceinline__ void ph_outproj(const Args& a, LAS unsigned char* lds, int G) {
    unsigned char* ws = a.ws;
    pg8::Gemm g{(const bf16*)(ws + WS_MIXED), (const bf16*)(ws + WS_WOUT), D};
    pg8::StaticOrder S; S.init(MTOK, D, D, G, (int)blockIdx.x);
    pg8::EpiOut E{(const bf16*)(ws + WS_XB), (bf16*)(ws + WS_HB), (unsigned char*)(ws + WS_HB8)};
    pg8::gemm_phase<false>(lds, g, S, E);
}
__device__ __forceinline__ void ph_gateup(const Args& a, LAS unsigned char* lds, int G) {
    unsigned char* ws = a.ws;
    const int T = moe_tables(a, lds);
    pg8::Gemm g{(const bf16*)(ws + WS_HB8), (const bf16*)(ws + WS_WGU), D / 2};
    pg8::MoeOrder S{(const LAS int*)(lds + LDSCTL_OFF + MISC_TSTART), (const LAS int*)(lds + LDSCTL_OFF + MISC_CNT), (const int*)(ws + WS_ROWTOK), T, G, moe_cpos((int)blockIdx.x, G), D / 2, 0, 1 << 24};
    pg8::EpiSwiglu E{(unsigned char*)(ws + WS_HID), (const float*)(ws + WS_ROWRS)};
    const int cp = moe_cpos((int)blockIdx.x, G);
    const int slot = conv_slot(4 * T, G, cp);
    if (slot >= 0) { S.i1 = slot; pg8::gemm_phase<true>(lds, g, S, E); conv_mine(a, 1, 4 * T, G, cp, 4096); S.i0 = slot; S.i1 = 1 << 24; pg8::gemm_phase<true>(lds, g, S, E); }
    else { pg8::gemm_phase<true>(lds, g, S, E); if (slot == -2) conv_mine(a, 1, 4 * T, G, cp, 4096); }
}
__device__ __forceinline__ void ph_down(const Args& a, LAS unsigned char* lds, int G) {
    unsigned char* ws = a.ws;
    const int T = ((const LAS int*)(lds + LDSCTL_OFF + MISC_TSTART))[NEXP];
    pg8::Gemm g{(const bf16*)(ws + WS_HID), (const bf16*)(ws + WS_WD), DEXP / 2};
    pg8::MoeOrder S{(const LAS int*)(lds + LDSCTL_OFF + MISC_TSTART), (const LAS int*)(lds + LDSCTL_OFF + MISC_CNT), nullptr, T, G, moe_cpos((int)blockIdx.x, G), DEXP / 2, 0, 1 << 24};
    pg8::EpiDown E{(unsigned char*)(ws + WS_YBUF), (const float*)(ws + WS_ROWGATE)};
    pg8::gemm_phase<true>(lds, g, S, E);
}
__device__ __forceinline__ void combine_store(float* o8, const u32x4& h, const u32x2& ya, const u32x2& yb) {
    const f32x2_t p0 = __builtin_amdgcn_cvt_pk_f32_fp8((int)ya.x, false), p1 = __builtin_amdgcn_cvt_pk_f32_fp8((int)ya.x, true), p2 = __builtin_amdgcn_cvt_pk_f32_fp8((int)ya.y, false), p3 = __builtin_amdgcn_cvt_pk_f32_fp8((int)ya.y, true);
    const f32x2_t r0 = __builtin_amdgcn_cvt_pk_f32_fp8((int)yb.x, false), r1 = __builtin_amdgcn_cvt_pk_f32_fp8((int)yb.x, true), r2 = __builtin_amdgcn_cvt_pk_f32_fp8((int)yb.y, false), r3 = __builtin_amdgcn_cvt_pk_f32_fp8((int)yb.y, true);
    f32x4 o0, o1;
    o0[0] = bflo(h.x) + (p0[0] + r0[0]) * Y8_INV; o0[1] = bfhi(h.x) + (p0[1] + r0[1]) * Y8_INV; o0[2] = bflo(h.y) + (p1[0] + r1[0]) * Y8_INV; o0[3] = bfhi(h.y) + (p1[1] + r1[1]) * Y8_INV;
    o1[0] = bflo(h.z) + (p2[0] + r2[0]) * Y8_INV; o1[1] = bfhi(h.z) + (p2[1] + r2[1]) * Y8_INV; o1[2] = bflo(h.w) + (p3[0] + r3[0]) * Y8_INV; o1[3] = bfhi(h.w) + (p3[1] + r3[1]) * Y8_INV;
    __builtin_nontemporal_store(o0, (f32x4*)o8); __builtin_nontemporal_store(o1, (f32x4*)(o8 + 4));
}
__device__ __forceinline__ void ph_combine(const Args& a, LAS unsigned char* lds, int G) {
    unsigned char* ws = a.ws;
    const int lane = threadIdx.x & 63, wave = threadIdx.x >> 6;
    const LAS int* tstart = (const LAS int*)(lds + LDSCTL_OFF + MISC_TSTART);
    const int* tokslot = (const int*)(ws + WS_TOKSLOT); const unsigned char* Y = ws + WS_YBUF; const bf16* HBp = (const bf16*)(ws + WS_HB);
    const int gw = blockIdx.x * 8 + wave, NGW = G * 8;
    for (int tb = gw; tb < MTOK; tb += 16 * NGW) {
        int mys0 = 0, mys1 = 0;
        { const int t = tb + (lane & 15) * NGW; if (t < MTOK) { const u32x2 sl = *(const u32x2*)(tokslot + 2 * t); mys0 = (int)sl.x; mys1 = (int)sl.y; } }
#pragma unroll
        for (int i = 0; i < 16; i += 2) {
            const int ta = tb + i * NGW, tc = tb + (i + 1) * NGW;
            if (ta >= MTOK) break;
            const bool two = tc < MTOK;
            const int a0 = __builtin_amdgcn_readlane(mys0, i), a1 = __builtin_amdgcn_readlane(mys1, i), c0 = __builtin_amdgcn_readlane(mys0, i + 1), c1 = __builtin_amdgcn_readlane(mys1, i + 1);
            const size_t ra0 = (size_t)(tstart[a0 >> 15] * 256 + (a0 & (ECAP - 1))), ra1 = (size_t)(tstart[a1 >> 15] * 256 + (a1 & (ECAP - 1)));
            const size_t rc0 = (size_t)(tstart[c0 >> 15] * 256 + (c0 & (ECAP - 1))), rc1 = (size_t)(tstart[c1 >> 15] * 256 + (c1 & (ECAP - 1)));
            u32x4 h[2][2]; u32x2 y0[2][2], y1[2][2];
#pragma unroll
            for (int j = 0; j < 2; ++j) { const int c = 8 * lane + 512 * j;
                h[0][j] = __builtin_nontemporal_load((const u32x4*)(HBp + (size_t)ta * D + c)); y0[0][j] = __builtin_nontemporal_load((const u32x2*)(Y + ra0 * D + c)); y1[0][j] = __builtin_nontemporal_load((const u32x2*)(Y + ra1 * D + c));
                h[1][j] = h[0][j]; y0[1][j] = y0[0][j]; y1[1][j] = y1[0][j];
                if (two) { h[1][j] = __builtin_nontemporal_load((const u32x4*)(HBp + (size_t)tc * D + c)); y0[1][j] = __builtin_nontemporal_load((const u32x2*)(Y + rc0 * D + c)); y1[1][j] = __builtin_nontemporal_load((const u32x2*)(Y + rc1 * D + c)); } }
#pragma unroll
            for (int j = 0; j < 2; ++j) { const int c = 8 * lane + 512 * j;
                combine_store(a.out + (size_t)ta * D + c, h[0][j], y0[0][j], y1[0][j]);
                if (two) combine_store(a.out + (size_t)tc * D + c, h[1][j], y0[1][j], y1[1][j]); }
        }
    }
}

#ifndef REP_PHASE
#define REP_PHASE -1
#endif
__global__ void __launch_bounds__(512, 2) hymba_fwd(Args a) {
    extern __shared__ __attribute__((aligned(16))) unsigned char lds_raw[];
    LAS unsigned char* lds = (LAS unsigned char*)lds_raw;
    const int tid = threadIdx.x, lane = tid & 63, wave = tid >> 6;
    const int G = gridDim.x;
    unsigned char* ws = a.ws;
    for (int u = tid; u < (LDS_BYTES - LDSCTL_OFF) / 4; u += 512) ((LAS unsigned*)(lds + LDSCTL_OFF))[u] = 0u;
    __syncthreads();
    XcdBarrier bar = xcd_barrier_post((unsigned*)(ws + WS_CTL) + CW_BAR, (volatile LAS unsigned*)(lds + LDSCTL_OFF + MISC_BAR));

    unsigned long long amp_t0 = 0, amp_t1 = 0;
    PH(0, p0_prologue(a, lds, G));
    PH(1, ph_inproj(a, lds, G, amp_t0, amp_t1));
    PH(2, p2_attn_conv(a, lds, G));
    PH(3, ph_outproj(a, lds, G));
    PH(4, p4_router(a, lds, G));
    PH(5, ph_gateup(a, lds, G));
    PH(6, ph_down(a, lds, G));
    if (AMP_PHASE == 7) amp_t0 = __builtin_amdgcn_s_memrealtime();
    ph_combine(a, lds, G);
    if (AMP_PHASE == 7) { xcd_barrier(bar); amp_t1 = __builtin_amdgcn_s_memrealtime(); }
    if (AMP_PHASE >= 0 && amp_t1 > amp_t0) { const unsigned long long span = (amp_t1 - amp_t0) * AMP_N, tw = __builtin_amdgcn_s_memrealtime(); while (__builtin_amdgcn_s_memrealtime() - tw < span) __builtin_amdgcn_s_sleep(8); }
#if REP_PHASE == 7
    xcd_barrier(bar); ph_combine(a, lds, G);
#endif
}

extern "C" void kernel_launch(void* const* d_in, const int* in_sizes, int n_in, void* d_out, int out_size, void* d_ws, size_t ws_size, hipStream_t stream) {
    static int grid = 0;
    if (grid == 0) {
        if (n_in != 20 || in_sizes[0] != MTOK * D || out_size != MTOK * D || ws_size < WS_END) {
            fprintf(stderr, "kernel_launch: unexpected shapes (n_in %d, in0 %d, out %d, ws %zu; need ws >= %zu); nothing launched\n", n_in, n_in > 0 ? in_sizes[0] : -1, out_size, ws_size, (size_t)WS_END);
            grid = -1; return; }
        int dev = 0, cus = 0;
        if (hipGetDevice(&dev) != hipSuccess || hipDeviceGetAttribute(&cus, hipDeviceAttributeMultiprocessorCount, dev) != hipSuccess) { grid = -1; return; }
        if (hipFuncSetAttribute((const void*)hymba_fwd, hipFuncAttributeMaxDynamicSharedMemorySize, LDS_BYTES) != hipSuccess) { fprintf(stderr, "kernel_launch: hipFuncSetAttribute failed\n"); grid = -1; return; }
        int per_cu = 0;
        if (hipOccupancyMaxActiveBlocksPerMultiprocessor(&per_cu, (const void*)hymba_fwd, 512, LDS_BYTES) != hipSuccess || per_cu < 1) { fprintf(stderr, "kernel_launch: occupancy query reports %d\n", per_cu); }
        (void)hipGetLastError();
        grid = cus;
    }
    if (grid < 0) return;
    if (hipMemsetAsync((char*)d_ws + WS_CTL, 0, CTL_BYTES, stream) != hipSuccess) return;
    Args a{};
    a.x = (const float*)d_in[0]; a.meta = (const float*)d_in[1]; a.rel_bias = (const float*)d_in[2]; a.mix_g = (const float*)d_in[3]; a.w_in = (const float*)d_in[4];
    a.q_g = (const float*)d_in[5]; a.k_g = (const float*)d_in[6]; a.sinks = (const float*)d_in[7]; a.conv_w = (const float*)d_in[8]; a.ga = (const float*)d_in[9];
    a.gc = (const float*)d_in[10]; a.w_out = (const float*)d_in[11]; a.ffn_g = (const float*)d_in[12]; a.w_gr = (const float*)d_in[13]; a.b_gr = (const float*)d_in[14];
    a.w_er = (const float*)d_in[15]; a.b_er = (const float*)d_in[16]; a.w_gate = (const float*)d_in[17]; a.w_up = (const float*)d_in[18]; a.w_down = (const float*)d_in[19];
    a.out = (float*)d_out; a.ws = (unsigned char*)d_ws;
    hipLaunchKernelGGL(hymba_fwd, dim3(grid), dim3(512), LDS_BYTES, stream, a);
}
```

```cpp
#include <hip/hip_runtime.h>
#include <cstdio>
#include <cstdint>
#ifndef AMP_PHASE
#define AMP_PHASE -1
#endif
#define AMP_N 4

#define LAS __attribute__((address_space(3)))
#define GAS __attribute__((address_space(1)))
typedef unsigned short bf16;
typedef short bf16x8 __attribute__((ext_vector_type(8)));
typedef short bf16x16_t __attribute__((ext_vector_type(16)));
typedef float f32x4 __attribute__((ext_vector_type(4)));
typedef float f32x16 __attribute__((ext_vector_type(16)));
typedef unsigned u32x4 __attribute__((ext_vector_type(4)));
typedef unsigned u32x2 __attribute__((ext_vector_type(2)));
typedef float f32x2_t __attribute__((ext_vector_type(2)));
typedef __bf16 bf16x2_t __attribute__((ext_vector_type(2)));

constexpr int NB = 4, SEQ = 8192, D = 1024, NMETA = 16;
constexpr int MTOK = NB * SEQ;
constexpr int MROWS = MTOK + 256;
constexpr int NPROJ = 2304;
constexpr int COL_K = 512, COL_V = 640, COL_CB = 768, COL_U = 1280;
constexpr int NEXP = 32, DEXP = 512, ECAP = 32768;
constexpr int MAXTILES = 288;
constexpr float EPS = 1e-6f;
constexpr float LOG2E = 1.4426950408889634f;

constexpr size_t MiB = 1u << 20;
constexpr size_t WS_CTL = 0, CTL_BYTES = 128 * 1024;
constexpr size_t WS_ROWTOK = 1 * MiB;
constexpr size_t WS_ROWRS = 5 * MiB;
constexpr size_t WS_ROWGATE = 9 * MiB;
constexpr size_t WS_TOKSLOT = 13 * MiB;
constexpr size_t WS_RSX = 13 * MiB + 512 * 1024;
constexpr size_t WS_WR = 14 * MiB;
constexpr size_t WS_WIN = 15 * MiB;
constexpr size_t WS_WOUT = 20 * MiB;
constexpr size_t WS_WGU = 22 * MiB;
constexpr size_t WS_HB8 = 54 * MiB;
constexpr size_t WS_WD = 86 * MiB;
constexpr size_t WS_XB = 118 * MiB;
constexpr size_t WS_PROJ = 184 * MiB;
constexpr size_t WS_HB = WS_PROJ;
constexpr size_t WS_HID = WS_PROJ + 64 * MiB;
constexpr size_t WS_YBUF = 332 * MiB;
constexpr size_t WS_MIXED = WS_YBUF;
constexpr size_t WS_END = 476 * MiB;
static_assert(WS_XB + (size_t)MROWS * D * 2 <= WS_PROJ && WS_PROJ + (size_t)MROWS * NPROJ * 2 <= WS_YBUF && WS_HID + (size_t)MAXTILES * 256 * DEXP * 2 <= WS_YBUF &&
              WS_YBUF + (size_t)MAXTILES * 256 * D * 2 <= WS_END, "d_ws map");
constexpr int CW_BAR = 4096;
constexpr int CW_CNT = 16384;
constexpr int CW_Q = 20480;

constexpr int LDS_BYTES = 147456;
constexpr int RING_BYTES = 131072;
constexpr int LDSCTL_OFF = 146432;
constexpr int SCAL_OFF = 142336;
constexpr int MISC_BAR = 0, MISC_TSTART = 64, MISC_CNT = 256, MISC_LCNT = 384, MISC_LBASE = 512;
constexpr int KN_OFF = 0, KN_HEAD = 32768;
constexpr int VT_OFF = 65536, VT_ROW = 528, VT_HEAD = 64 * VT_ROW;
constexpr int BIAS_OFF = VT_OFF + 2 * VT_HEAD;
constexpr int SSA_OFF = BIAS_OFF + 6144;
static_assert(SSA_OFF + 4096 <= LDSCTL_OFF, "P2 LDS map");

__device__ __forceinline__ unsigned pk2(float lo, float hi) { f32x2_t v = {lo, hi}; bf16x2_t b = __builtin_convertvector(v, bf16x2_t); return __builtin_bit_cast(unsigned, b); }
typedef int v8i_t __attribute__((ext_vector_type(8)));
typedef int v4i_t __attribute__((ext_vector_type(4)));
constexpr float Y8_SCALE = 16.0f, Y8_INV = 1.0f / 16.0f;
constexpr float W8_SCALE = 32.0f, W8_INV = 1.0f / 32.0f;
__device__ __forceinline__ unsigned pk4_fp8(float a, float b, float c, float d) { int w = 0; w = __builtin_amdgcn_cvt_pk_fp8_f32(a, b, w, false); w = __builtin_amdgcn_cvt_pk_fp8_f32(c, d, w, true); return (unsigned)w; }
__device__ __forceinline__ float bflo(unsigned w) { return __uint_as_float(w << 16); }
__device__ __forceinline__ float bfhi(unsigned w) { return __uint_as_float(w & 0xffff0000u); }
__device__ __forceinline__ float wave_sum(float v) {
#pragma unroll
    for (int o = 1; o < 64; o <<= 1) v += __shfl_xor(v, o);
    return v;
}
#define LDS_WAIT() asm volatile("s_waitcnt lgkmcnt(0)" ::: "memory")
#define VM_WAIT() asm volatile("s_waitcnt vmcnt(0)" ::: "memory")

#define XB_TMO      128
#define XB_XCNT(j)  (256  + 64 * (j))
#define XB_XSUB(j)  (1280 + 64 * (j))
#define XB_XGEN(j)  (2304 + 64 * (j))
#define XB_TOP      3328
#define XB_TOPGEN   3392
#define XCD_BAR_WORDS 3456
#define XB_SPIN_CAP (1u << 18)
__device__ __forceinline__ unsigned xb_ld(unsigned* p)              { return __hip_atomic_load(p, __ATOMIC_RELAXED, __HIP_MEMORY_SCOPE_AGENT); }
__device__ __forceinline__ unsigned xb_add(unsigned* p, unsigned v) { return __hip_atomic_fetch_add(p, v, __ATOMIC_RELAXED, __HIP_MEMORY_SCOPE_AGENT); }
__device__ __forceinline__ unsigned xb_xcc_id() { return (unsigned)__builtin_amdgcn_s_getreg((3 << 11) | 20) & 0xFu; }
#define XB_SPIN(cond, bar) do { unsigned _sp = 0; while (cond) { __builtin_amdgcn_s_sleep(1); \
    if ((++_sp & 255u) == 0u) { if (xb_ld(&(bar)[XB_TMO])) break; if (_sp > XB_SPIN_CAP) { atomicAdd(&(bar)[XB_TMO], 1u); break; } } } } while (0)
struct XcdBarrier { unsigned* bar; unsigned x; volatile LAS unsigned* st; };
__device__ __forceinline__ XcdBarrier xcd_barrier_post(unsigned* bar, volatile LAS unsigned* st) {
    XcdBarrier b; b.bar = bar; b.x = xb_xcc_id(); b.st = st;
    if (threadIdx.x == 0) (void)xb_add(&bar[XB_XCNT(b.x)], 1u);
    return b;
}
__device__ __forceinline__ void xcd_barrier_complete(unsigned* bar, unsigned x, unsigned& nloc, unsigned& nx) {
    const unsigned G = gridDim.x * gridDim.y * gridDim.z;
    unsigned sum, cnt, mine, sp = 0u;
    for (;;) {
        sum = 0u; cnt = 0u; mine = 0u;
#pragma unroll
        for (unsigned j = 0; j < 16; ++j) { const unsigned c = xb_ld(&bar[XB_XCNT(j)]); sum += c; cnt += (c > 0u) ? 1u : 0u; mine = (j == x) ? c : mine; }
        if (sum == G) break;
        __builtin_amdgcn_s_sleep(1);
        if ((++sp & 255u) == 0u) { if (xb_ld(&bar[XB_TMO])) break; if (sp > XB_SPIN_CAP) { atomicAdd(&bar[XB_TMO], 1u); break; } }
    }
    nloc = mine > 0u ? mine : 1u; nx = cnt > 0u ? cnt : 1u;
}
__device__ __forceinline__ void xcd_barrier(const XcdBarrier& b) {
    asm volatile("s_waitcnt vmcnt(0)" ::: "memory");
    __syncthreads();
    if (threadIdx.x == 0) {
        unsigned* bar = b.bar;
        __builtin_amdgcn_s_waitcnt(0);
        unsigned nloc = b.st[0], nx = b.st[1];
        if (nloc == 0u) { xcd_barrier_complete(bar, b.x, nloc, nx); b.st[0] = nloc; b.st[1] = nx; }
        const unsigned old = xb_add(&bar[XB_XSUB(b.x)], 1u);
        const unsigned gen = old / nloc;
        if (old + 1u == (gen + 1u) * nloc) {
            __builtin_amdgcn_fence(__ATOMIC_RELEASE, "agent");
            asm volatile("s_waitcnt vmcnt(0)" ::: "memory");
            const unsigned og = xb_add(&bar[XB_TOP], 1u);
            const unsigned tg = og / nx;
            if (og + 1u == (tg + 1u) * nx) xb_add(&bar[XB_TOPGEN], 1u);
            else XB_SPIN(xb_ld(&bar[XB_TOPGEN]) == tg, bar);
            __builtin_amdgcn_fence(__ATOMIC_ACQUIRE, "agent");
            xb_add(&bar[XB_XGEN(b.x)], 1u);
            asm volatile("s_waitcnt vmcnt(0)" ::: "memory");
        } else {
            XB_SPIN(xb_ld(&bar[XB_XGEN(b.x)]) == gen, bar);
            __builtin_amdgcn_fence(__ATOMIC_ACQUIRE, "agent");
            asm volatile("s_waitcnt vmcnt(0)" ::: "memory");
        }
    }
    __syncthreads();
}

__device__ __forceinline__ int moe_cpos(int c, int G) { if (G != 256) return c; const int x = c & 7, q = c >> 3; return ((x * 8 + (q & 7)) << 2) + (q >> 3); }
__device__ __forceinline__ int moe_cpos_last(int c, int G) { if (G != 256) return c; const int x = c & 7, q = c >> 3; return ((x + 8 * (q >> 2)) << 2) + (q & 3); }
namespace pg8 {
constexpr int BM = 256, BK = 64, HALF = 128, HTB = HALF * BK * 2, STAGE_BYTES = 8 * HTB, NXCD = 8, WGM = 8;
__host__ __device__ __forceinline__ int lds_byte(int r, int c) { const int st = (r >> 4) * 2 + (c >> 5), rr = r & 15, cc = c & 31, ob = rr * 64 + cc * 2; return st * 1024 + (ob ^ (((ob >> 9) & 1) << 5)); }
__host__ __device__ __forceinline__ void stage_rc(int b, int& R, int& C) { const int st = b / 1024, sb = b % 1024, swz = sb ^ (((sb >> 9) & 1) << 5); R = (st >> 1) * 16 + swz / 64; C = (st & 1) * 32 + (swz % 64) / 2; }
__host__ __device__ __forceinline__ int perm32(int rho) { const int n = rho >> 4, i = rho & 15; return 8 * (i >> 2) + 4 * n + (i & 3); }

struct Unit { int pm, pn, xa, xb; };
struct Gemm { const bf16* A; const bf16* Bt; int K; };

struct StaticOrder {
    int nM, nN, nwg, G, c, K, i0, i1;
    __device__ void init(int M, int N, int K_, int G_, int c_) { nM = M / BM; nN = N / BM; nwg = nM * nN; G = G_; c = c_; K = K_; i0 = 0; i1 = 1 << 24; }
    __device__ __forceinline__ bool next(int i, Unit& u) const {
        i += i0; if (i >= i1) return false;
        const long L = (long)i * G + c; if (L >= nwg) return false;
        int wgid = (int)L; { const int q = nwg / NXCD, r = nwg % NXCD, xcd = wgid % NXCD, off = wgid / NXCD; wgid = (xcd < r ? xcd * (q + 1) : r * (q + 1) + (xcd - r) * q) + off; }
        const int nig = WGM * nN, gid = wgid / nig, fm = gid * WGM, gsz = (nM - fm) < WGM ? (nM - fm) : WGM;
        u.pm = fm + ((wgid % nig) % gsz); u.pn = (wgid % nig) / gsz; u.xa = 0; u.xb = 0; return true;
    }
    __device__ __forceinline__ void aoff(const Unit& u, const int (&R)[2], const int (&C)[2], unsigned (&o)[2][2]) const {
#pragma unroll
        for (int h = 0; h < 2; ++h)
#pragma unroll
            for (int i = 0; i < 2; ++i) o[h][i] = (unsigned)((u.pm * BM + h * HALF + R[i]) * K + C[i]) * 2u;
    }
};

struct MoeOrder {
    const LAS int* tstart; const LAS int* cnt; const int* rowtok;
    int T, G, c, K, i0, i1, clast;
    __device__ __forceinline__ bool next(int i, Unit& u) const {
        i += i0; if (i >= i1) return false;
        const int L = i * G + (i == (T * 4) / G ? clast : c); if (L >= T * 4) return false;
        const int rt = L >> 2, j = L & 3;
        int e = 0;
#pragma unroll
        for (int k = 1; k < NEXP; ++k) e += (rt >= tstart[k]) ? 1 : 0;
        u.pm = rt; u.pn = __builtin_amdgcn_readfirstlane(e * 4 + j);
        u.xa = __builtin_amdgcn_readfirstlane((rt - tstart[e]) * 256); u.xb = __builtin_amdgcn_readfirstlane(cnt[e]); return true;
    }
    __device__ __forceinline__ void aoff(const Unit& u, const int (&R)[2], const int (&C)[2], unsigned (&o)[2][2]) const {
        if (rowtok) {
            const int* rt = rowtok + (size_t)(u.pn >> 2) * ECAP;
#pragma unroll
            for (int h = 0; h < 2; ++h)
#pragma unroll
                for (int i = 0; i < 2; ++i) { const int pos = u.xa + h * HALF + R[i]; int tok = 0; if (pos < u.xb) tok = rt[pos]; o[h][i] = (unsigned)(tok * K + C[i]) * 2u; }
        } else {
#pragma unroll
            for (int h = 0; h < 2; ++h)
#pragma unroll
                for (int i = 0; i < 2; ++i) o[h][i] = (unsigned)((u.pm * BM + h * HALF + R[i]) * K + C[i]) * 2u;
        }
    }
};

template <bool FP8, class Epi, class Sched>
__device__ __forceinline__ void gemm_phase(LAS unsigned char* lds, const Gemm g, const Sched& S, const Epi& E) {
    const int tid = threadIdx.x, wid = __builtin_amdgcn_readfirstlane(tid >> 6), lane = tid & 63, wr = wid >> 2, wc = wid & 3, fr = lane & 15, fq = lane >> 4;
    const int K = g.K, nt = K / BK;
    int Rr[2], Cc[2]; unsigned voffB[2];
#pragma unroll
    for (int i = 0; i < 2; ++i) { int R, C; stage_rc(tid * 16 + i * 8192, R, C); const int Rb = (R & ~31) + perm32(R & 31); Rr[i] = R; Cc[i] = C; voffB[i] = FP8 ? (unsigned)(Rb * 128 + C * 2) : (unsigned)(Rb * K + C) * 2u; }
    const size_t kstep = (size_t)(BK * 2);
    const size_t kstepB = FP8 ? (size_t)32768 : kstep;
    const size_t hstep = FP8 ? (size_t)16384 : (size_t)HALF * K * 2;
    const size_t tstep = FP8 ? (size_t)nt * 32768 : 2 * hstep;
    const unsigned ldsw = (unsigned)wid * 1024u;
    const int aoff = lds_byte(wr * 64 + fr, fq * 8), boff = lds_byte(wc * 32 + fr, fq * 8);
#define PG8_SA(b, h) (((b) * 2 + (h)) * HTB)
#define PG8_SB(b, h) ((4 + (b) * 2 + (h)) * HTB)
#define PG8_STAGE(bufoff, gbase, voff) do { _Pragma("unroll") for (int _i = 0; _i < 2; ++_i) \
        __builtin_amdgcn_global_load_lds((const unsigned*)((const char*)(gbase) + (voff)[_i]), (LAS unsigned*)(lds + (bufoff) + ldsw + _i * 8192), 16, 0, 0); } while (0)
#define PG8_LDA_BF(dst, b, h) do { _Pragma("unroll") for (int m = 0; m < 4; ++m) _Pragma("unroll") for (int k = 0; k < 2; ++k) dst[m][k] = *(const LAS bf16x8*)(lds + PG8_SA(b, h) + aoff + m * 2048 + k * 1024); } while (0)
#define PG8_LDB_BF(dst, b, h) do { _Pragma("unroll") for (int n = 0; n < 2; ++n) _Pragma("unroll") for (int k = 0; k < 2; ++k) dst[n][k] = *(const LAS bf16x8*)(lds + PG8_SB(b, h) + boff + n * 2048 + k * 1024); } while (0)
#define PG8_MMA_BF(ai, bj, At, Bt) do { __builtin_amdgcn_s_setprio(1); _Pragma("unroll") for (int m = 0; m < 4; ++m) _Pragma("unroll") for (int n = 0; n < 2; ++n) _Pragma("unroll") for (int k = 0; k < 2; ++k) \
        acc[ai][bj][m][n] = __builtin_amdgcn_mfma_f32_16x16x32_bf16(Bt[n][k], At[m][k], acc[ai][bj][m][n], 0, 0, 0); __builtin_amdgcn_s_setprio(0); } while (0)
#define PG8_LDA_F8(dst, b, h) do { _Pragma("unroll") for (int m = 0; m < 4; ++m) { const v4i_t lo_ = *(const LAS v4i_t*)(lds + PG8_SA(b, h) + aoff + m * 2048), hi_ = *(const LAS v4i_t*)(lds + PG8_SA(b, h) + aoff + m * 2048 + 1024); \
        dst##8[m] = __builtin_shufflevector(lo_, hi_, 0, 1, 2, 3, 4, 5, 6, 7); } } while (0)
#define PG8_LDB_F8(dst, b, h) do { _Pragma("unroll") for (int n = 0; n < 2; ++n) { const v4i_t lo_ = *(const LAS v4i_t*)(lds + PG8_SB(b, h) + boff + n * 2048), hi_ = *(const LAS v4i_t*)(lds + PG8_SB(b, h) + boff + n * 2048 + 1024); \
        dst##8[n] = __builtin_shufflevector(lo_, hi_, 0, 1, 2, 3, 4, 5, 6, 7); } } while (0)
#define PG8_MMA_F8(ai, bj, At, Bt) do { __builtin_amdgcn_s_setprio(1); _Pragma("unroll") for (int m = 0; m < 4; ++m) _Pragma("unroll") for (int n = 0; n < 2; ++n) \
        asm volatile("v_mfma_scale_f32_16x16x128_f8f6f4 %0, %1, %2, %0, %3, %3 op_sel_hi:[0,0,0]" : "+v"(acc[ai][bj][m][n]) : "v"(Bt##8[n]), "v"(At##8[m]), "v"(f8scale)); \
        __builtin_amdgcn_s_setprio(0); } while (0)
#define PG8_F8_DRAIN asm volatile("s_nop 15\n\ts_nop 15" ::: "memory")
#define PG8_LDA(dst, b, h) do { if constexpr (FP8) PG8_LDA_F8(dst, b, h); else PG8_LDA_BF(dst, b, h); } while (0)
#define PG8_LDB(dst, b, h) do { if constexpr (FP8) PG8_LDB_F8(dst, b, h); else PG8_LDB_BF(dst, b, h); } while (0)
#define PG8_MMA(ai, bj, At, Bt) do { if constexpr (FP8) PG8_MMA_F8(ai, bj, At, Bt); else PG8_MMA_BF(ai, bj, At, Bt); } while (0)
#define PG8_WAIT_V(n) asm volatile("s_waitcnt vmcnt(" #n ")" ::: "memory")
#define PG8_WAIT_L(n) asm volatile("s_waitcnt lgkmcnt(" #n ")" ::: "memory")
#define PG8_BAR __builtin_amdgcn_s_barrier()
#define PG8_SCHED __builtin_amdgcn_sched_barrier(0)
    int f8scale = 0x7F7F7F7F; asm volatile("" : "+v"(f8scale));
    Unit cur, nxt; int ui = 0;
    if (!S.next(0, cur)) return;
    f32x4 acc[2][2][4][2];
#pragma unroll
    for (int a = 0; a < 2; ++a)
#pragma unroll
        for (int b = 0; b < 2; ++b)
#pragma unroll
            for (int m = 0; m < 4; ++m)
#pragma unroll
                for (int n = 0; n < 2; ++n) acc[a][b][m][n] = (f32x4){0.f, 0.f, 0.f, 0.f};
    bf16x8 At[4][2], B0[2][2], B1[2][2];
    v8i_t At8[4], B08[2], B18[2];
    unsigned oc[2][2], on[2][2];
    S.aoff(cur, Rr, Cc, oc);
    int sl_cur = 0;
    E.pre(cur, lds + SCAL_OFF, wid, lane);
    const char* const gA = (const char*)g.A;
    const char* cB = (const char*)g.Bt + (size_t)cur.pn * tstep;
    PG8_STAGE(PG8_SB(0, 0), cB, voffB); PG8_STAGE(PG8_SB(0, 1), cB + hstep, voffB); PG8_STAGE(PG8_SA(0, 0), gA, oc[0]); PG8_STAGE(PG8_SA(0, 1), gA, oc[1]);
    if (wr == 1) PG8_BAR;
    PG8_WAIT_V(2); PG8_BAR;
    PG8_STAGE(PG8_SB(1, 0), cB + kstepB, voffB); PG8_STAGE(PG8_SA(1, 0), gA + kstep, oc[0]); PG8_STAGE(PG8_SB(1, 1), cB + hstep + kstepB, voffB);
    PG8_WAIT_V(6); PG8_BAR;
    for (;;) {
        const bool has_next = S.next(ui + 1, nxt);
        const int sl_nxt = sl_cur == 2 ? 0 : sl_cur + 1;
        if (has_next) { S.aoff(nxt, Rr, Cc, on); E.pre(nxt, lds + SCAL_OFF + sl_nxt * 1024, wid, lane); }
        else {
#pragma unroll
            for (int h = 0; h < 2; ++h)
#pragma unroll
                for (int i = 0; i < 2; ++i) on[h][i] = oc[h][i];
        }
        const char* nB = has_next ? (const char*)g.Bt + (size_t)nxt.pn * tstep : cB;
#pragma unroll 1
        for (int t = 0; t < nt; t += 2) {
            const bool last = (t == nt - 2);
            const char* a1 = gA + (size_t)(t + 1) * kstep;
            const char* a2 = last ? gA : gA + (size_t)(t + 2) * kstep; const char* b2 = last ? nB : cB + (size_t)(t + 2) * kstepB;
            const char* a3 = a2 + kstep; const char* b3 = b2 + kstepB;
            unsigned o2[2][2];
#pragma unroll
            for (int h = 0; h < 2; ++h)
#pragma unroll
                for (int i = 0; i < 2; ++i) o2[h][i] = last ? on[h][i] : oc[h][i];
            PG8_LDB(B0, 0, 0); PG8_LDB(B1, 0, 1); PG8_SCHED; PG8_LDA(At, 0, 0); PG8_STAGE(PG8_SA(1, 1), a1, oc[1]);
            PG8_WAIT_V(8); PG8_WAIT_L(0); PG8_BAR; PG8_MMA(0, 0, At, B0); PG8_MMA(0, 1, At, B1); PG8_BAR; PG8_SCHED;
            PG8_LDA(At, 0, 1); PG8_STAGE(PG8_SB(0, 0), b2, voffB); PG8_STAGE(PG8_SB(0, 1), b2 + hstep, voffB); PG8_STAGE(PG8_SA(0, 0), a2, o2[0]);
            PG8_WAIT_V(8); PG8_WAIT_L(0); PG8_BAR; PG8_MMA(1, 0, At, B0); PG8_MMA(1, 1, At, B1); PG8_BAR; PG8_SCHED;
            PG8_LDB(B0, 1, 0); PG8_LDB(B1, 1, 1); PG8_SCHED; PG8_LDA(At, 1, 0); PG8_STAGE(PG8_SA(0, 1), a2, o2[1]);
            PG8_WAIT_V(8); PG8_WAIT_L(0); PG8_BAR; PG8_MMA(0, 0, At, B0); PG8_MMA(0, 1, At, B1); PG8_BAR; PG8_SCHED;
            PG8_LDA(At, 1, 1); PG8_STAGE(PG8_SB(1, 0), b3, voffB); PG8_STAGE(PG8_SB(1, 1), b3 + hstep, voffB); PG8_STAGE(PG8_SA(1, 0), a3, o2[0]);
            PG8_WAIT_V(8); PG8_WAIT_L(0); PG8_BAR; PG8_MMA(1, 0, At, B0); PG8_MMA(1, 1, At, B1); PG8_BAR; PG8_SCHED;
        }
        if constexpr (FP8) PG8_F8_DRAIN;
        if (wr == 0) PG8_BAR;
        E(acc, cur, wr, wc, fr, fq, (const LAS float*)(lds + SCAL_OFF + sl_cur * 1024));
        if (!has_next) break;
#pragma unroll
        for (int a = 0; a < 2; ++a)
#pragma unroll
            for (int b = 0; b < 2; ++b)
#pragma unroll
                for (int m = 0; m < 4; ++m)
#pragma unroll
                    for (int n = 0; n < 2; ++n) acc[a][b][m][n] = (f32x4){0.f, 0.f, 0.f, 0.f};
        cur = nxt; cB = nB; ++ui; sl_cur = sl_nxt;
#pragma unroll
        for (int h = 0; h < 2; ++h)
#pragma unroll
            for (int i = 0; i < 2; ++i) oc[h][i] = on[h][i];
        if (wr == 1) PG8_BAR;
    }
    PG8_WAIT_V(0);
    PG8_BAR;
#undef PG8_SA
#undef PG8_SB
#undef PG8_STAGE
#undef PG8_LDA
#undef PG8_LDA_BF
#undef PG8_LDA_F8
#undef PG8_LDB_BF
#undef PG8_LDB_F8
#undef PG8_MMA_BF
#undef PG8_MMA_F8
#undef PG8_F8_DRAIN
#undef PG8_LDB
#undef PG8_MMA
#undef PG8_WAIT_V
#undef PG8_WAIT_L
#undef PG8_BAR
#undef PG8_SCHED
}

__device__ __forceinline__ u32x4 widen8(u32x2 a, u32x2 b) {
    auto r0 = __builtin_amdgcn_permlane16_swap(a.x, b.x, false, false); auto r1 = __builtin_amdgcn_permlane16_swap(a.y, b.y, false, false);
    u32x4 o; o.x = r0[0]; o.y = r1[0]; o.z = r0[1]; o.w = r1[1]; return o;
}
struct EpiProj {
    bf16* O; const float* rs;
    __device__ __forceinline__ void pre(const Unit& u, LAS unsigned char* slot, int wid, int lane) const {
        if (wid < 4) __builtin_amdgcn_global_load_lds((const unsigned*)(rs + u.pm * BM + wid * 64 + lane), (LAS unsigned*)(slot + wid * 256), 4, 0, 0);
    }
    __device__ __forceinline__ void operator()(const f32x4 (&acc)[2][2][4][2], const Unit& u, int wr, int wc, int fr, int fq, const LAS float* scal) const {
        const int row0 = u.pm * BM + wr * 64 + fr, col0 = u.pn * BM + wc * 32 + 8 * fq;
        float sc[2][4];
#pragma unroll
        for (int ai = 0; ai < 2; ++ai)
#pragma unroll
            for (int m = 0; m < 4; ++m) sc[ai][m] = scal[ai * HALF + wr * 64 + m * 16 + fr];
        if (u.pn >= 5) {
#pragma unroll
            for (int ai = 0; ai < 2; ++ai)
#pragma unroll
                for (int m = 0; m < 4; ++m) { const int row = row0 + ai * HALF + m * 16; const float s2 = sc[ai][m] * sc[ai][m];
                    const f32x4 v0 = acc[ai][0][m][0] * acc[ai][1][m][0] * s2, v1 = acc[ai][0][m][1] * acc[ai][1][m][1] * s2;
                    u32x4 w; w.x = pk2(v0[0], v0[1]); w.y = pk2(v0[2], v0[3]); w.z = pk2(v1[0], v1[1]); w.w = pk2(v1[2], v1[3]);
                    *(u32x4*)(O + (size_t)row * NPROJ + COL_U + (u.pn - 5) * 128 + wc * 32 + 8 * fq) = w; }
            return;
        }
#pragma unroll
        for (int ai = 0; ai < 2; ++ai)
#pragma unroll
            for (int m = 0; m < 4; ++m) { const int row = row0 + ai * HALF + m * 16; const float s = sc[ai][m]; bf16* rowp = O + (size_t)row * NPROJ + col0;
#pragma unroll
                for (int bj = 0; bj < 2; ++bj) { const f32x4 v0 = acc[ai][bj][m][0] * s, v1 = acc[ai][bj][m][1] * s;
                    u32x4 w; w.x = pk2(v0[0], v0[1]); w.y = pk2(v0[2], v0[3]); w.z = pk2(v1[0], v1[1]); w.w = pk2(v1[2], v1[3]);
                    *(u32x4*)(rowp + bj * HALF) = w; } }
    }
};
struct EpiOut {
    const bf16* xb; bf16* hb; unsigned char* hb8;
    __device__ __forceinline__ void pre(const Unit&, LAS unsigned char*, int, int) const {}
    __device__ __forceinline__ void operator()(const f32x4 (&acc)[2][2][4][2], const Unit& u, int wr, int wc, int fr, int fq, const LAS float*) const {
        const int row0 = u.pm * BM + wr * 64 + fr, col0 = u.pn * BM + wc * 32 + 8 * fq;
        u32x4 xr[2][4][2];
#pragma unroll
        for (int ai = 0; ai < 2; ++ai)
#pragma unroll
            for (int m = 0; m < 4; ++m) { const size_t off = (size_t)(row0 + ai * HALF + m * 16) * D + col0;
#pragma unroll
                for (int bj = 0; bj < 2; ++bj) xr[ai][m][bj] = *(const u32x4*)(xb + off + bj * HALF); }
#pragma unroll
        for (int ai = 0; ai < 2; ++ai)
#pragma unroll
            for (int m = 0; m < 4; ++m) { const size_t off = (size_t)(row0 + ai * HALF + m * 16) * D + col0;
                u32x2 w8[2];
#pragma unroll
                for (int bj = 0; bj < 2; ++bj) { const u32x4 xw = xr[ai][m][bj]; const f32x4 a0 = acc[ai][bj][m][0], a1 = acc[ai][bj][m][1];
                    const float h0 = bflo(xw.x) + a0[0], h1 = bfhi(xw.x) + a0[1], h2 = bflo(xw.y) + a0[2], h3 = bfhi(xw.y) + a0[3];
                    const float h4 = bflo(xw.z) + a1[0], h5 = bfhi(xw.z) + a1[1], h6 = bflo(xw.w) + a1[2], h7 = bfhi(xw.w) + a1[3];
                    u32x4 w; w.x = pk2(h0, h1); w.y = pk2(h2, h3); w.z = pk2(h4, h5); w.w = pk2(h6, h7);
                    *(u32x4*)(hb + off + bj * HALF) = w;
                    w8[bj].x = pk4_fp8(h0, h1, h2, h3); w8[bj].y = pk4_fp8(h4, h5, h6, h7); }
                const int odd = fq & 1;
                *(u32x4*)(hb8 + off + odd * HALF - 8 * odd) = widen8(w8[0], w8[1]); }
    }
};
__device__ __forceinline__ float silu_mul(float g, float u) { return g * __builtin_amdgcn_rcpf(1.0f + __builtin_amdgcn_exp2f(-g * LOG2E)) * u; }
struct EpiSwiglu {
    unsigned char* hid; const float* rowrs;
    __device__ __forceinline__ void pre(const Unit& u, LAS unsigned char* slot, int wid, int lane) const {
        if (wid < 4) __builtin_amdgcn_global_load_lds((const unsigned*)(rowrs + (size_t)(u.pn >> 2) * ECAP + u.xa + wid * 64 + lane), (LAS unsigned*)(slot + wid * 256), 4, 0, 0);
    }
    __device__ __forceinline__ void operator()(const f32x4 (&acc)[2][2][4][2], const Unit& u, int wr, int wc, int fr, int fq, const LAS float* scal) const {
        const int j = u.pn & 3;
        float sc[2][4];
#pragma unroll
        for (int ai = 0; ai < 2; ++ai)
#pragma unroll
            for (int m = 0; m < 4; ++m) { const int rl = ai * HALF + wr * 64 + m * 16 + fr; sc[ai][m] = (u.xa + rl < u.xb) ? scal[rl] * W8_INV : 0.f; }
#pragma unroll
        for (int ai = 0; ai < 2; ++ai)
#pragma unroll
            for (int mp = 0; mp < 2; ++mp) {
                u32x2 w[2];
#pragma unroll
                for (int mm = 0; mm < 2; ++mm) { const int m = 2 * mp + mm; const float s = sc[ai][m], sl = -s * LOG2E, s2 = s * s;
                    u32x2 o;
#pragma unroll
                    for (int n = 0; n < 2; ++n) { const f32x4 G = acc[ai][0][m][n], U = acc[ai][1][m][n]; const f32x4 t = G * sl; f32x4 e;
#pragma unroll
                        for (int i = 0; i < 4; ++i) e[i] = __builtin_amdgcn_exp2f(t[i]);
                        const f32x4 d = e + 1.0f; f32x4 r;
#pragma unroll
                        for (int i = 0; i < 4; ++i) r[i] = __builtin_amdgcn_rcpf(d[i]);
                        const f32x4 v = (G * U) * (r * s2);
                        o[n] = pk4_fp8(v[0], v[1], v[2], v[3]); }
                    w[mm] = o; }
                const int odd = fq & 1, rl = ai * HALF + wr * 64 + (2 * mp + odd) * 16 + fr;
                *(u32x4*)(hid + (size_t)(u.pm * BM + rl) * DEXP + j * 128 + wc * 32 + 8 * (fq - odd)) = widen8(w[0], w[1]); }
    }
};
struct EpiDown {
    unsigned char* y; const float* rowgate;
    __device__ __forceinline__ void pre(const Unit& u, LAS unsigned char* slot, int wid, int lane) const {
        if (wid < 4) __builtin_amdgcn_global_load_lds((const unsigned*)(rowgate + (size_t)(u.pn >> 2) * ECAP + u.xa + wid * 64 + lane), (LAS unsigned*)(slot + wid * 256), 4, 0, 0);
    }
    __device__ __forceinline__ void operator()(const f32x4 (&acc)[2][2][4][2], const Unit& u, int wr, int wc, int fr, int fq, const LAS float* scal) const {
        const int j = u.pn & 3;
        float sc[2][4];
#pragma unroll
        for (int ai = 0; ai < 2; ++ai)
#pragma unroll
            for (int m = 0; m < 4; ++m) { const int rl = ai * HALF + wr * 64 + m * 16 + fr; sc[ai][m] = (u.xa + rl < u.xb) ? scal[rl] * (W8_INV * Y8_SCALE) : 0.f; }
#pragma unroll
        for (int ai = 0; ai < 2; ++ai)
#pragma unroll
            for (int m = 0; m < 4; ++m) { const int rl = ai * HALF + wr * 64 + m * 16 + fr; const float s = sc[ai][m];
                const int odd = fq & 1;
                unsigned char* rowp = y + (size_t)(u.pm * BM + rl) * D + j * BM + wc * 32 + 8 * (fq - odd) + odd * HALF;
                u32x2 w[2];
#pragma unroll
                for (int bj = 0; bj < 2; ++bj) { const f32x4 v0 = acc[ai][bj][m][0] * s, v1 = acc[ai][bj][m][1] * s;
                    w[bj].x = pk4_fp8(v0[0], v0[1], v0[2], v0[3]); w[bj].y = pk4_fp8(v1[0], v1[1], v1[2], v1[3]); }
                *(u32x4*)rowp = widen8(w[0], w[1]); }
    }
};
}

struct Args {
    const float* x; const float* meta; const float* rel_bias; const float* mix_g; const float* w_in; const float* q_g; const float* k_g; const float* sinks;
    const float* conv_w; const float* ga; const float* gc; const float* w_out; const float* ffn_g; const float* w_gr; const float* b_gr; const float* w_er; const float* b_er;
    const float* w_gate; const float* w_up; const float* w_down;
    float* out; unsigned char* ws;
};

struct TrRegs { f32x4 v[2][8]; float sk[8]; };
template <bool SCALE>
__device__ __forceinline__ void tr_load(TrRegs& t, const float* W, int ldw, const float* ks, int k0, int n0, int lane) {
    const int q = lane & 7, kg = lane >> 3;
    const float* src = W + (size_t)(k0 + 8 * kg) * ldw + n0 + 4 * q;
#pragma unroll
    for (int hh = 0; hh < 2; ++hh)
#pragma unroll
        for (int i = 0; i < 8; ++i) t.v[hh][i] = __builtin_nontemporal_load((const f32x4*)(src + (size_t)i * ldw + 32 * hh));
    if (SCALE) { const f32x4 s0 = *(const f32x4*)(ks + k0 + 8 * kg), s1 = *(const f32x4*)(ks + k0 + 8 * kg + 4);
#pragma unroll
        for (int i = 0; i < 4; ++i) { t.sk[i] = s0[i]; t.sk[4 + i] = s1[i]; } }
    else {
#pragma unroll
        for (int i = 0; i < 8; ++i) t.sk[i] = 1.f; }
}
__device__ __forceinline__ void tr_store(const TrRegs& t, bf16* WT, int ldt, int k0, int drow0, int lane) {
    const int q = lane & 7, kg = lane >> 3;
#pragma unroll
    for (int hh = 0; hh < 2; ++hh)
#pragma unroll
        for (int ni = 0; ni < 4; ++ni) {
            u32x4 o; o.x = pk2(t.v[hh][0][ni] * t.sk[0], t.v[hh][1][ni] * t.sk[1]); o.y = pk2(t.v[hh][2][ni] * t.sk[2], t.v[hh][3][ni] * t.sk[3]);
            o.z = pk2(t.v[hh][4][ni] * t.sk[4], t.v[hh][5][ni] * t.sk[5]); o.w = pk2(t.v[hh][6][ni] * t.sk[6], t.v[hh][7][ni] * t.sk[7]);
            *(u32x4*)(WT + (size_t)(drow0 + 32 * hh + 4 * q + ni) * ldt + k0 + 8 * kg) = o; }
}
template <bool SCALE>
__device__ __forceinline__ void tr_item(const float* W, int ldw, const float* ks, bf16* WT, int ldt, int k0, int n0, int drow0, int lane) {
    TrRegs t; tr_load<SCALE>(t, W, ldw, ks, k0, n0, lane); tr_store(t, WT, ldt, k0, drow0, lane);
}

struct TrItem { f32x4 v[16]; float sk[16]; };
__device__ __forceinline__ void conv_item_load(TrItem& t, const Args& a, int pool, int it, int lane) {
    const int q = lane & 7, kg = lane >> 3;
    const float* W; int ldw, k0, n0;
    if (pool == 0) { int r = it; const int up = r >= 4096 ? 1 : 0; if (up) r -= 4096; const int e = r >> 7, qq = r & 127; k0 = 128 * (qq >> 4); n0 = 32 * (qq & 15); W = (up ? a.w_up : a.w_gate) + (size_t)e * D * DEXP; ldw = DEXP; }
    else { const int e = it >> 7, qq = it & 127; k0 = 128 * (qq >> 5); n0 = 32 * (qq & 31); W = a.w_down + (size_t)e * DEXP * D; ldw = D; }
    const float* src = W + (size_t)(k0 + 16 * kg) * ldw + n0 + 4 * q;
#pragma unroll
    for (int i = 0; i < 16; ++i) t.v[i] = *(const f32x4*)(src + (size_t)i * ldw);
    if (pool == 0) {
#pragma unroll
        for (int i4 = 0; i4 < 4; ++i4) { const f32x4 sv = *(const f32x4*)(a.ffn_g + k0 + 16 * kg + 4 * i4);
#pragma unroll
            for (int i = 0; i < 4; ++i) t.sk[4 * i4 + i] = sv[i] * W8_SCALE; }
    } else {
#pragma unroll
        for (int i = 0; i < 16; ++i) t.sk[i] = W8_SCALE;
    }
}
__device__ __forceinline__ void conv_item_store(const TrItem& t, const Args& a, int pool, int it, int lane) {
    const int q = lane & 7, kg = lane >> 3;
    unsigned char* WT; int ldt, k0, drow0;
    if (pool == 0) { int r = it; const int up = r >= 4096 ? 1 : 0; if (up) r -= 4096; const int e = r >> 7, qq = r & 127, n0 = 32 * (qq & 15); k0 = 128 * (qq >> 4);
        WT = a.ws + WS_WGU; ldt = D; drow0 = e * 1024 + (n0 >> 7) * 256 + up * 128 + (n0 & 127); }
    else { const int e = it >> 7, qq = it & 127; k0 = 128 * (qq >> 5); WT = a.ws + WS_WD; ldt = DEXP; drow0 = e * 1024 + 32 * (qq & 31); }
#pragma unroll
    for (int ni = 0; ni < 4; ++ni) {
        u32x4 o;
        o.x = pk4_fp8(t.v[0][ni] * t.sk[0], t.v[1][ni] * t.sk[1], t.v[2][ni] * t.sk[2], t.v[3][ni] * t.sk[3]);
        o.y = pk4_fp8(t.v[4][ni] * t.sk[4], t.v[5][ni] * t.sk[5], t.v[6][ni] * t.sk[6], t.v[7][ni] * t.sk[7]);
        o.z = pk4_fp8(t.v[8][ni] * t.sk[8], t.v[9][ni] * t.sk[9], t.v[10][ni] * t.sk[10], t.v[11][ni] * t.sk[11]);
        o.w = pk4_fp8(t.v[12][ni] * t.sk[12], t.v[13][ni] * t.sk[13], t.v[14][ni] * t.sk[14], t.v[15][ni] * t.sk[15]);
        const int R = drow0 + 4 * q + ni;
        *(u32x4*)(WT + ((size_t)((R >> 8) * (ldt >> 7) + (k0 >> 7)) * 256 + (R & 255)) * 128 + 16 * kg) = o; }
}
__device__ __forceinline__ void conv_pool(const Args& a, int pool, int rank, int nranks, int total) {
    const int lane = threadIdx.x & 63, wave = threadIdx.x >> 6;
    const int gwv = rank * 8 + wave, NW = nranks * 8;
    if (gwv >= total) return;
    const int n = (total - gwv + NW - 1) / NW;
    const int last = gwv + (n - 1) * NW;
    TrItem r0, r1;
    conv_item_load(r0, a, pool, min(gwv, last), lane); conv_item_load(r1, a, pool, min(gwv + NW, last), lane);
    for (int j = 0; j < n; j += 2) {
        const int b0 = gwv + j * NW;
        conv_item_store(r0, a, pool, min(b0, last), lane);      conv_item_load(r0, a, pool, min(b0 + 2 * NW, last), lane);
        conv_item_store(r1, a, pool, min(b0 + NW, last), lane); conv_item_load(r1, a, pool, min(b0 + 3 * NW, last), lane);
    }
}
__device__ __forceinline__ void conv_pool16(const Args& a, int pool, int rank, int nranks, int nchunks) {
    const int lane = threadIdx.x & 63, wave = threadIdx.x >> 6;
    int c = rank;
    if (c >= nchunks) return;
    TrItem r0, r1;
    conv_item_load(r0, a, pool, 16 * c + wave, lane); conv_item_load(r1, a, pool, 16 * c + 8 + wave, lane);
    for (;;) {
        const int cn = c + nranks; const bool more = cn < nchunks;
        conv_item_store(r0, a, pool, 16 * c + wave, lane);     if (more) conv_item_load(r0, a, pool, 16 * cn + wave, lane);
        conv_item_store(r1, a, pool, 16 * c + 8 + wave, lane); if (more) conv_item_load(r1, a, pool, 16 * cn + 8 + wave, lane);
        if (!more) break;
        c = cn;
    }
}
__device__ __forceinline__ int conv_slot(int nunits, int G, int c) {
    const int rem = nunits % G;
    if (rem == 0) return -2;
    if (c < rem) return -1;
    const int nmine = nunits / G;
    return (c - rem) % (nmine + 1);
}
__device__ __forceinline__ void conv_mine(const Args& a, int pool, int nunits, int G, int c, int total) {
    const int rem = nunits % G;
    if (rem == 0) conv_pool(a, pool, c, G, total); else conv_pool(a, pool, c - rem, G - rem, total);
}
__device__ __forceinline__ void conv_dyn(const Args& a, int pool, int lo, int hi, LAS unsigned char* lds, unsigned* q) {
    const int lane = threadIdx.x & 63, wave = threadIdx.x >> 6;
    volatile LAS int* tk = (volatile LAS int*)(lds + LDSCTL_OFF + 640);
    for (;;) {
        __syncthreads();
        if (threadIdx.x == 0) *tk = (int)__hip_atomic_fetch_add(q, 1u, __ATOMIC_RELAXED, __HIP_MEMORY_SCOPE_AGENT);
        __syncthreads();
        const int base = lo + (*tk) * 8;
        if (base >= hi) break;
        const int it = base + wave;
        if (it < hi) { TrItem r; conv_item_load(r, a, pool, it, lane); conv_item_store(r, a, pool, it, lane); }
    }
}

__device__ __forceinline__ void p0_prologue(const Args& a, LAS unsigned char* lds, int G) {
    const int tid = threadIdx.x, lane = tid & 63, wave = tid >> 6;
    unsigned char* ws = a.ws;
    const int gw = blockIdx.x * 8 + wave, NGW = G * 8;
    bf16* Win = (bf16*)(ws + WS_WIN); bf16* Wout = (bf16*)(ws + WS_WOUT);
    constexpr int I_IN = 16 * 36, I_OUT = 16 * 16;
    constexpr int NITEMS = I_IN + I_OUT;
    bf16* Wr = (bf16*)(ws + WS_WR);
    for (int idx = (G - 1 - (int)blockIdx.x) * 512 + tid; idx < 48 * 1024; idx += G * 512) { const int c = idx >> 10, k = idx & 1023;
        float v = 0.f; if (c < 4) v = a.w_gr[k * 4 + c]; else if (c < 36) v = a.w_er[k * 32 + (c - 4)];
        Wr[idx] = (bf16)(pk2(v * a.ffn_g[k], 0.f) & 0xffffu); }
    bf16* XB = (bf16*)(ws + WS_XB); float* rsx = (float*)(ws + WS_RSX);
    constexpr int NPAIR = MROWS / 2;
    for (int wi = gw; wi < NITEMS + NPAIR; wi += NGW) {
        if (wi < NITEMS) {
            int r = wi;
            if (r < I_IN) { const int kb = r / 36, nb = r % 36, n0 = 64 * nb;
                int drow = n0;
                if (n0 >= 1792) { const int c = n0 - 1792; drow = 1280 + (c >> 7) * 256 + 128 + (c & 127); } else if (n0 >= 1280) { const int c = n0 - 1280; drow = 1280 + (c >> 7) * 256 + (c & 127); }
                tr_item<true>(a.w_in, NPROJ, a.mix_g, Win, D, 64 * kb, n0, drow, lane); continue; } r -= I_IN;
            { const int kb = r >> 4, nb = r & 15; const int k0 = 64 * kb; const float* ks = k0 < 512 ? a.ga : a.gc - 512;
                tr_item<true>(a.w_out, D, ks, Wout, D, k0, 64 * nb, 64 * nb, lane); }
                continue;
        }
        const int m0 = 2 * (wi - NITEMS);
        f32x4 v[2][4];
#pragma unroll
        for (int rr = 0; rr < 2; ++rr) { const int m = m0 + rr;
            if (m < MTOK + NMETA) { const float* src = m < MTOK ? a.x + (size_t)m * D : a.meta + (size_t)(m - MTOK) * D;
#pragma unroll
                for (int j = 0; j < 4; ++j) v[rr][j] = __builtin_nontemporal_load((const f32x4*)(src + 4 * lane + 256 * j));
            } else {
#pragma unroll
                for (int j = 0; j < 4; ++j) v[rr][j] = (f32x4){0.f, 0.f, 0.f, 0.f};
            } }
#pragma unroll
        for (int rr = 0; rr < 2; ++rr) { const int m = m0 + rr;
            float s = 0.f;
#pragma unroll
            for (int j = 0; j < 4; ++j) s += (v[rr][j].x * v[rr][j].x + v[rr][j].y * v[rr][j].y) + (v[rr][j].z * v[rr][j].z + v[rr][j].w * v[rr][j].w);
            s = wave_sum(s);
            if (lane == 0) rsx[m] = (m < MTOK + NMETA) ? rsqrtf(s * (1.f / D) + EPS) : 0.f;
#pragma unroll
            for (int j = 0; j < 4; ++j) { u32x2 w; w.x = pk2(v[rr][j].x, v[rr][j].y); w.y = pk2(v[rr][j].z, v[rr][j].w); *(u32x2*)(XB + (size_t)m * D + 4 * lane + 256 * j) = w; } }
    }
}

__device__ __forceinline__ int t5_bucket(int n) {
    if (n < 16) return n;
    const float v = logf((float)n * 0.0625f) * (16.0f / 2.0794415416798357f);
    int l = 16 + (int)v; return l < 31 ? l : 31;
}
__device__ __forceinline__ int crow(int r, int hi) { return (r & 3) + 8 * (r >> 2) + 4 * hi; }

__device__ __forceinline__ void p2_attn_conv(const Args& a, LAS unsigned char* lds, int G) {
    const int tid = threadIdx.x, lane = tid & 63, wave = __builtin_amdgcn_readfirstlane(tid >> 6);
    const bf16* PROJ = (const bf16*)(a.ws + WS_PROJ); bf16* MIXED = (bf16*)(a.ws + WS_MIXED);
    LAS float* biasT = (LAS float*)(lds + BIAS_OFF); LAS float* ssA = (LAS float*)(lds + SSA_OFF); LAS float* bndH = (LAS float*)(lds + SSA_OFF + 4096);
    for (int unit = blockIdx.x; unit < NB * 64; unit += G) {
        const int b = unit >> 6, blk = unit & 63;
        __syncthreads();
        u32x4 qraw[4];
        {
            const size_t qrow0 = (size_t)(b * SEQ + blk * 128 + (lane & 31));
#pragma unroll
            for (int s4 = 0; s4 < 4; ++s4) qraw[s4] = __builtin_nontemporal_load((const u32x4*)(PROJ + qrow0 * NPROJ + wave * 64 + 16 * s4 + 8 * (lane >> 5)));
        }
        const f32x4 gk0 = *(const f32x4*)(a.k_g + (tid & 7) * 8), gk1 = *(const f32x4*)(a.k_g + (tid & 7) * 8 + 4);
        const f32x4 gq0 = *(const f32x4*)(a.q_g + (tid & 7) * 8), gq1 = *(const f32x4*)(a.q_g + (tid & 7) * 8 + 4);
        const f32x4 gs0 = gk0 * gq0 * (0.125f * LOG2E), gs1 = gk1 * gq1 * (0.125f * LOG2E);
        float ggm;
        { const f32x4 p0 = gk0 * gq0, p1 = gk1 * gq1;
          ggm = fmaxf(fmaxf(fmaxf(fabsf(p0[0]), fabsf(p0[1])), fmaxf(fabsf(p0[2]), fabsf(p0[3]))), fmaxf(fmaxf(fabsf(p1[0]), fabsf(p1[1])), fmaxf(fabsf(p1[2]), fabsf(p1[3]))));
          ggm = fmaxf(ggm, __shfl_xor(ggm, 1)); ggm = fmaxf(ggm, __shfl_xor(ggm, 2)); ggm = fmaxf(ggm, __shfl_xor(ggm, 4)); }
        if (tid < 8) { float bm = a.rel_bias[tid];
            for (int bkt = 1; bkt < 32; ++bkt) bm = fmaxf(bm, a.rel_bias[bkt * 8 + tid]);
            bndH[tid] = (8.0f * 1.02f * LOG2E) * ggm + LOG2E * bm; }
#pragma unroll 1
        for (int pass = 0; pass < 2; ++pass) {
            u32x4 kraw[4], vraw[4];
#pragma unroll
            for (int i4 = 0; i4 < 4; ++i4) {
                const int idx = (pass * 4 + i4) * 512 + tid; const int chunk = idx & 7, kvh = (idx >> 3) & 1, wk = idx >> 4;
                const int tpos = blk * 128 - 128 + wk;
                const int row = tpos >= 0 ? b * SEQ + tpos : MTOK + NMETA + tpos;
                kraw[i4] = (u32x4){0u, 0u, 0u, 0u}; vraw[i4] = (u32x4){0u, 0u, 0u, 0u};
                if (tpos >= -NMETA) { const bf16* p = PROJ + (size_t)row * NPROJ + kvh * 64 + chunk * 8; kraw[i4] = *(const u32x4*)(p + COL_K); vraw[i4] = *(const u32x4*)(p + COL_V); }
            }
#pragma unroll
            for (int i4 = 0; i4 < 4; ++i4) {
                const int idx = (pass * 4 + i4) * 512 + tid; const int chunk = idx & 7, kvh = (idx >> 3) & 1, wk = idx >> 4;
                float kf[8];
#pragma unroll
                for (int j = 0; j < 4; ++j) { kf[2 * j] = bflo(kraw[i4][j]); kf[2 * j + 1] = bfhi(kraw[i4][j]); }
                float ss = 0.f;
#pragma unroll
                for (int j = 0; j < 8; ++j) ss += kf[j] * kf[j];
                ss += __shfl_xor(ss, 1); ss += __shfl_xor(ss, 2); ss += __shfl_xor(ss, 4);
                const float sc = rsqrtf(ss * (1.f / 64.f) + EPS);
                u32x4 kw;
                kw.x = pk2(kf[0] * sc * gs0[0], kf[1] * sc * gs0[1]); kw.y = pk2(kf[2] * sc * gs0[2], kf[3] * sc * gs0[3]);
                kw.z = pk2(kf[4] * sc * gs1[0], kf[5] * sc * gs1[1]); kw.w = pk2(kf[6] * sc * gs1[2], kf[7] * sc * gs1[3]);
                *(LAS u32x4*)(lds + KN_OFF + kvh * KN_HEAD + wk * 128 + ((chunk ^ (wk & 7)) << 4)) = kw;
                const int slot = ((wk & ~12) | ((wk & 4) << 1) | ((wk & 8) >> 1)) ^ (chunk << 3);
                LAS unsigned char* vt = lds + VT_OFF + kvh * VT_HEAD + (chunk * 8) * VT_ROW + slot * 2;
#pragma unroll
                for (int j = 0; j < 8; ++j) *(LAS unsigned short*)(vt + j * VT_ROW) = (unsigned short)(vraw[i4][j >> 1] >> (16 * (j & 1)));
            }
        }
        __syncthreads();
        for (int e2 = tid; e2 < 8 * 192; e2 += 512) { const int h = e2 / 192, dist = e2 % 192 - 31; biasT[e2] = (dist >= 0 && dist < 128) ? a.rel_bias[t5_bucket(dist) * 8 + h] * LOG2E - bndH[h] : -1e30f; }
        __syncthreads();
        {
            const int h = wave, kvh = wave >> 2, r = lane & 31, hi = lane >> 5;
            const LAS unsigned char* KnB = lds + KN_OFF + kvh * KN_HEAD; const LAS unsigned char* VTB = lds + VT_OFF + kvh * VT_HEAD;
            const float sink = a.sinks[h] * LOG2E - bndH[h];
            const int wkmin = (blk == 0) ? (128 - NMETA) : 0;
            for (int qi = 0; qi < 4; ++qi) {
                const size_t qrow = (size_t)(b * SEQ + blk * 128 + 32 * qi + r);
                float ss = 0.f;
#pragma unroll
                for (int s = 0; s < 4; ++s)
#pragma unroll
                    for (int j = 0; j < 4; ++j) { const float lo = bflo(qraw[s][j]), hh = bfhi(qraw[s][j]); ss += lo * lo + hh * hh; }
                ss += __shfl_xor(ss, 32);
                const float qsc = rsqrtf(ss * (1.f / 64.f) + EPS);
                bf16x8 qf[4];
#pragma unroll
                for (int s = 0; s < 4; ++s) { u32x4 w;
#pragma unroll
                    for (int j = 0; j < 4; ++j) w[j] = pk2(bflo(qraw[s][j]) * qsc, bfhi(qraw[s][j]) * qsc);
                    qf[s] = __builtin_bit_cast(bf16x8, w); }
                if (qi < 3) {
#pragma unroll
                    for (int s = 0; s < 4; ++s) qraw[s] = __builtin_nontemporal_load((const u32x4*)(PROJ + (qrow + 32) * NPROJ + h * 64 + 16 * s + 8 * hi));
                }
                const LAS float* bt = biasT + h * 192 + 31 + 128 + r - 4 * hi;
                f32x16 S[5];
#pragma unroll
                for (int k5 = 0; k5 < 5; ++k5) {
                    const int key = 32 * (qi + k5) + r;
                    f32x16 accs;
#pragma unroll
                    for (int i = 0; i < 16; ++i) accs[i] = bt[-32 * k5 - ((i & 3) + 8 * (i >> 2))];
#pragma unroll
                    for (int s = 0; s < 4; ++s) { const bf16x8 kfr = *(const LAS bf16x8*)(KnB + key * 128 + (((2 * s + hi) ^ (key & 7)) << 4));
                        accs = __builtin_amdgcn_mfma_f32_32x32x16_bf16(kfr, qf[s], accs, 0, 0, 0); }
                    S[k5] = accs;
                }
                if (blk == 0) {
#pragma unroll
                    for (int k5 = 0; k5 < 5; ++k5)
#pragma unroll
                        for (int i = 0; i < 16; ++i) if (32 * (qi + k5) + crow(i, hi) < wkmin) S[k5][i] = -1e30f;
                }
                float l = 0.f;
#pragma unroll
                for (int k5 = 0; k5 < 5; ++k5)
#pragma unroll
                    for (int i = 0; i < 16; ++i) { const float p = __builtin_amdgcn_exp2f(S[k5][i]); S[k5][i] = p; l += p; }
                l += __shfl_xor(l, 32);
                l += __builtin_amdgcn_exp2f(sink);
                f32x16 O0, O1;
#pragma unroll
                for (int i = 0; i < 16; ++i) { O0[i] = 0.f; O1[i] = 0.f; }
#pragma unroll
                for (int k5 = 0; k5 < 5; ++k5)
#pragma unroll
                    for (int s2 = 0; s2 < 2; ++s2) {
                        u32x4 pw;
#pragma unroll
                        for (int j = 0; j < 4; ++j) pw[j] = pk2(S[k5][8 * s2 + 2 * j], S[k5][8 * s2 + 2 * j + 1]);
                        const bf16x8 pf = __builtin_bit_cast(bf16x8, pw);
                        const int sl = 32 * (qi + k5) + 16 * s2 + 8 * hi;
                        const bf16x8 v0 = *(const LAS bf16x8*)(VTB + r * VT_ROW + ((sl ^ ((r >> 3) << 3)) << 1)), v1 = *(const LAS bf16x8*)(VTB + (32 + r) * VT_ROW + ((sl ^ ((4 + (r >> 3)) << 3)) << 1));
                        O0 = __builtin_amdgcn_mfma_f32_32x32x16_bf16(v0, pf, O0, 0, 0, 0);
                        O1 = __builtin_amdgcn_mfma_f32_32x32x16_bf16(v1, pf, O1, 0, 0, 0);
                    }
                const float inv = 1.0f / l;
                float so = 0.f;
#pragma unroll
                for (int i = 0; i < 16; ++i) { O0[i] *= inv; O1[i] *= inv; so += O0[i] * O0[i] + O1[i] * O1[i]; }
                so += __shfl_xor(so, 32);
                if (hi == 0) ssA[qi * 256 + r * 8 + h] = so;
                __syncthreads();
                float tot = 0.f;
#pragma unroll
                for (int hh = 0; hh < 8; ++hh) tot += ssA[qi * 256 + r * 8 + hh];
                const float rsa = rsqrtf(tot * (1.f / 512.f) + EPS);
                unsigned char* orow = (unsigned char*)(MIXED + qrow * D + h * 64) + 16 * hi;
#pragma unroll
                for (int kp = 0; kp < 2; ++kp) {
                    u32x2 a0, b0, a1, b1;
                    a0.x = pk2(O0[8 * kp] * rsa, O0[8 * kp + 1] * rsa); a0.y = pk2(O0[8 * kp + 2] * rsa, O0[8 * kp + 3] * rsa);
                    b0.x = pk2(O0[8 * kp + 4] * rsa, O0[8 * kp + 5] * rsa); b0.y = pk2(O0[8 * kp + 6] * rsa, O0[8 * kp + 7] * rsa);
                    a1.x = pk2(O1[8 * kp] * rsa, O1[8 * kp + 1] * rsa); a1.y = pk2(O1[8 * kp + 2] * rsa, O1[8 * kp + 3] * rsa);
                    b1.x = pk2(O1[8 * kp + 4] * rsa, O1[8 * kp + 5] * rsa); b1.y = pk2(O1[8 * kp + 6] * rsa, O1[8 * kp + 7] * rsa);
                    { auto r = __builtin_amdgcn_permlane32_swap(a0.x, b0.x, false, false); a0.x = r[0]; b0.x = r[1]; }
                    { auto r = __builtin_amdgcn_permlane32_swap(a0.y, b0.y, false, false); a0.y = r[0]; b0.y = r[1]; }
                    { auto r = __builtin_amdgcn_permlane32_swap(a1.x, b1.x, false, false); a1.x = r[0]; b1.x = r[1]; }
                    { auto r = __builtin_amdgcn_permlane32_swap(a1.y, b1.y, false, false); a1.y = r[0]; b1.y = r[1]; }
                    *(u32x4*)(orow + 32 * kp) = (u32x4){a0.x, a0.y, b0.x, b0.y};
                    *(u32x4*)(orow + 64 + 32 * kp) = (u32x4){a1.x, a1.y, b1.x, b1.y};
                }
            }
        }
        {
            const int c0 = 8 * lane;
            float cw[3][8];
#pragma unroll
            for (int j = 0; j < 3; ++j) { const f32x4 w0 = *(const f32x4*)(a.conv_w + j * 512 + c0), w1 = *(const f32x4*)(a.conv_w + j * 512 + c0 + 4);
#pragma unroll
                for (int i = 0; i < 4; ++i) { cw[j][i] = w0[i]; cw[j][4 + i] = w1[i]; } }
            const int tbase = blk * 128 + wave * 16;
            float u2[8], u1[8];
            {
                u32x4 hu[2];
#pragma unroll
                for (int i = 0; i < 2; ++i) { const int tpos = tbase - 2 + i; const size_t row = tpos >= 0 ? (size_t)(b * SEQ + tpos) : (size_t)(MTOK + NMETA + tpos);
                    hu[i] = *(const u32x4*)(PROJ + row * NPROJ + COL_U + c0); }
#pragma unroll
                for (int j = 0; j < 4; ++j) { u2[2 * j] = bflo(hu[0][j]); u2[2 * j + 1] = bfhi(hu[0][j]); u1[2 * j] = bflo(hu[1][j]); u1[2 * j + 1] = bfhi(hu[1][j]); }
            }
            u32x4 rb[4], ru[4];
#pragma unroll
            for (int i = 0; i < 4; ++i) { const bf16* p = PROJ + (size_t)(b * SEQ + tbase + i) * NPROJ + c0; rb[i] = __builtin_nontemporal_load((const u32x4*)(p + COL_CB)); ru[i] = __builtin_nontemporal_load((const u32x4*)(p + COL_U)); }
#pragma unroll
            for (int g = 0; g < 4; ++g) {
                u32x4 nb[4], nu[4];
                if (g < 3) {
#pragma unroll
                    for (int i = 0; i < 4; ++i) { const bf16* p = PROJ + (size_t)(b * SEQ + tbase + 4 * g + 4 + i) * NPROJ + c0; nb[i] = __builtin_nontemporal_load((const u32x4*)(p + COL_CB)); nu[i] = __builtin_nontemporal_load((const u32x4*)(p + COL_U)); }
                }
                float cv[4][8], ssq[4];
#pragma unroll
                for (int i = 0; i < 4; ++i) {
                    float u0[8];
#pragma unroll
                    for (int j = 0; j < 4; ++j) { u0[2 * j] = bflo(ru[i][j]); u0[2 * j + 1] = bfhi(ru[i][j]); }
                    float ss = 0.f;
#pragma unroll
                    for (int j = 0; j < 4; ++j) {
                        const float y0 = cw[0][2 * j] * u2[2 * j] + cw[1][2 * j] * u1[2 * j] + cw[2][2 * j] * u0[2 * j];
                        const float y1 = cw[0][2 * j + 1] * u2[2 * j + 1] + cw[1][2 * j + 1] * u1[2 * j + 1] + cw[2][2 * j + 1] * u0[2 * j + 1];
                        cv[i][2 * j] = bflo(rb[i][j]) * y0; cv[i][2 * j + 1] = bfhi(rb[i][j]) * y1; ss += cv[i][2 * j] * cv[i][2 * j] + cv[i][2 * j + 1] * cv[i][2 * j + 1]; }
                    ssq[i] = ss;
#pragma unroll
                    for (int j = 0; j < 8; ++j) { u2[j] = u1[j]; u1[j] = u0[j]; }
                }
#pragma unroll
                for (int o = 1; o < 64; o <<= 1) {
#pragma unroll
                    for (int i = 0; i < 4; ++i) ssq[i] += __shfl_xor(ssq[i], o); }
#pragma unroll
                for (int i = 0; i < 4; ++i) {
                    const float rcs = rsqrtf(ssq[i] * (1.f / 512.f) + EPS);
                    u32x4 w; w.x = pk2(cv[i][0] * rcs, cv[i][1] * rcs); w.y = pk2(cv[i][2] * rcs, cv[i][3] * rcs); w.z = pk2(cv[i][4] * rcs, cv[i][5] * rcs); w.w = pk2(cv[i][6] * rcs, cv[i][7] * rcs);
                    *(u32x4*)(MIXED + (size_t)(b * SEQ + tbase + 4 * g + i) * D + 512 + c0) = w; }
                if (g < 3) {
#pragma unroll
                    for (int i = 0; i < 4; ++i) { rb[i] = nb[i]; ru[i] = nu[i]; }
                }
            }
        }
    }
}

__device__ __forceinline__ void p4_router(const Args& a, LAS unsigned char* lds, int G) {
    const int tid = threadIdx.x, lane = tid & 63, wave = __builtin_amdgcn_readfirstlane(tid >> 6);
    const bf16* HB = (const bf16*)(a.ws + WS_HB); const bf16* Wr = (const bf16*)(a.ws + WS_WR);
    int* rowtok = (int*)(a.ws + WS_ROWTOK); float* rowrs = (float*)(a.ws + WS_ROWRS); float* rowgate = (float*)(a.ws + WS_ROWGATE); int* tokslot = (int*)(a.ws + WS_TOKSLOT);
    unsigned* gcnt = (unsigned*)(a.ws + WS_CTL) + CW_CNT;
    LAS int* lcnt = (LAS int*)(lds + LDSCTL_OFF + MISC_LCNT); LAS int* lbase = (LAS int*)(lds + LDSCTL_OFF + MISC_LBASE);
    LAS float* lg = (LAS float*)(lds + 99328 + wave * 4096);
    constexpr int WR_ROW = 2064;
    __syncthreads();
#pragma unroll
    for (int i = 0; i < 12; ++i) { const int id = i * 512 + tid, row = id >> 7, cc = id & 127;
        *(LAS u32x4*)(lds + row * WR_ROW + cc * 16) = *(const u32x4*)(Wr + (size_t)row * D + cc * 8); }
    for (int chunk = blockIdx.x; chunk < MTOK / 128; chunk += G) {
        __syncthreads();
        if (tid < NEXP) lcnt[tid] = 0;
        __syncthreads();
        const int t0 = chunk * 128 + wave * 16, r16 = lane & 15, q4 = lane >> 4;
        f32x4 acc[3];
#pragma unroll
        for (int c = 0; c < 3; ++c) acc[c] = (f32x4){0.f, 0.f, 0.f, 0.f};
        float ss = 0.f;
        const bf16* arow = HB + (size_t)(t0 + r16) * D + 8 * q4;
        const LAS unsigned char* brow = lds + r16 * WR_ROW + q4 * 16;
        u32x4 aw[32];
#pragma unroll
        for (int ks = 0; ks < 32; ++ks) aw[ks] = *(const u32x4*)(arow + ks * 32);
#pragma unroll
        for (int ks = 0; ks < 32; ++ks) {
#pragma unroll
            for (int j = 0; j < 4; ++j) { const float lo = bflo(aw[ks][j]), hh = bfhi(aw[ks][j]); ss += lo * lo + hh * hh; }
            const bf16x8 af = __builtin_bit_cast(bf16x8, aw[ks]);
#pragma unroll
            for (int c = 0; c < 3; ++c) { const bf16x8 bfr = *(const LAS bf16x8*)(brow + c * 16 * WR_ROW + ks * 64); acc[c] = __builtin_amdgcn_mfma_f32_16x16x32_bf16(af, bfr, acc[c], 0, 0, 0); }
        }
        ss += __shfl_xor(ss, 16); ss += __shfl_xor(ss, 32);
#pragma unroll
        for (int c = 0; c < 3; ++c)
#pragma unroll
            for (int i = 0; i < 4; ++i) lg[(4 * q4 + i) * 49 + 16 * c + r16] = acc[c][i];
        LDS_WAIT(); __builtin_amdgcn_wave_barrier();
        int e1 = 0, e2 = 0, p1 = 0, p2 = 0; float g1 = 0.f, g2 = 0.f, rs = 0.f;
        if (lane < 16) {
            rs = rsqrtf(ss * (1.f / D) + EPS);
            const LAS float* my = lg + lane * 49;
            float gl[4];
#pragma unroll
            for (int c = 0; c < 4; ++c) gl[c] = my[c] * rs + a.b_gr[c];
            int gi = 0; float gm = gl[0];
#pragma unroll
            for (int c = 1; c < 4; ++c) if (gl[c] > gm) { gm = gl[c]; gi = c; }
            float gs = 0.f;
#pragma unroll
            for (int c = 0; c < 4; ++c) gs += __expf(gl[c] - gm);
            const float gp = 1.0f / gs;
            float el[8];
#pragma unroll
            for (int e = 0; e < 8; ++e) el[e] = my[4 + gi * 8 + e] * rs + a.b_er[gi * 8 + e];
            int i1 = 0; float v1 = el[0];
#pragma unroll
            for (int e = 1; e < 8; ++e) if (el[e] > v1) { v1 = el[e]; i1 = e; }
            int i2 = -1; float v2 = -3.0e38f;
#pragma unroll
            for (int e = 0; e < 8; ++e) if (e != i1 && el[e] > v2) { v2 = el[e]; i2 = e; }
            const float ex = __expf(v2 - v1); const float w1 = 1.0f / (1.0f + ex), w2 = ex * w1;
            e1 = gi * 8 + i1; e2 = gi * 8 + i2; g1 = gp * w1; g2 = gp * w2;
            p1 = __hip_atomic_fetch_add(lcnt + e1, 1, __ATOMIC_RELAXED, __HIP_MEMORY_SCOPE_WORKGROUP);
            p2 = __hip_atomic_fetch_add(lcnt + e2, 1, __ATOMIC_RELAXED, __HIP_MEMORY_SCOPE_WORKGROUP);
        }
        __syncthreads();
        if (tid < NEXP) { const int n = lcnt[tid]; int base = 0; if (n > 0) base = (int)__hip_atomic_fetch_add(gcnt + 64 * tid, (unsigned)n, __ATOMIC_RELAXED, __HIP_MEMORY_SCOPE_AGENT); lbase[tid] = base; }
        __syncthreads();
        if (lane < 16) {
            const int tok = t0 + lane;
            const int s1 = e1 * ECAP + lbase[e1] + p1, s2 = e2 * ECAP + lbase[e2] + p2;
            rowtok[s1] = tok; rowrs[s1] = rs; rowgate[s1] = g1;
            rowtok[s2] = tok; rowrs[s2] = rs; rowgate[s2] = g2;
            tokslot[2 * tok] = s1; tokslot[2 * tok + 1] = s2;
        }
    }
}

__device__ __forceinline__ int moe_tables(const Args& a, LAS unsigned char* lds) {
    LAS int* tstart = (LAS int*)(lds + LDSCTL_OFF + MISC_TSTART); LAS int* cnt = (LAS int*)(lds + LDSCTL_OFF + MISC_CNT);
    unsigned* gcnt = (unsigned*)(a.ws + WS_CTL) + CW_CNT;
    __syncthreads();
    if (threadIdx.x < 64) {
        const int lane = threadIdx.x;
        int c = 0; if (lane < NEXP) c = (int)__hip_atomic_load(gcnt + 64 * lane, __ATOMIC_RELAXED, __HIP_MEMORY_SCOPE_AGENT);
        const int tl = (c + 255) >> 8; int s = tl;
#pragma unroll
        for (int d = 1; d < NEXP; d <<= 1) { const int o = __shfl_up(s, d); if (lane >= d) s += o; }
        if (lane < NEXP) { cnt[lane] = c; tstart[lane] = s - tl; }
        if (lane == NEXP - 1) tstart[NEXP] = s;
    }
    __syncthreads();
    return tstart[NEXP];
}

#define PH(k, call) do { if (AMP_PHASE == (k)) amp_t0 = __builtin_amdgcn_s_memrealtime(); call; xcd_barrier(bar); if (AMP_PHASE == (k)) amp_t1 = __builtin_amdgcn_s_memrealtime(); if (REP_PHASE == (k)) { call; xcd_barrier(bar); } } while (0)
__device__ __forceinline__ void ph_inproj(const Args& a, LAS unsigned char* lds, int G, unsigned long long& amp_t0, unsigned long long& amp_t1) {
    unsigned char* ws = a.ws;
    pg8::Gemm g{(const bf16*)(ws + WS_XB), (const bf16*)(ws + WS_WIN), D};
    pg8::StaticOrder S; S.init(MROWS, NPROJ, D, G, (int)blockIdx.x);
    pg8::EpiProj E{(bf16*)(ws + WS_PROJ), (const float*)(ws + WS_RSX)};
    constexpr int NU = (MROWS / 256) * (NPROJ / 256);
    constexpr int GU_ITEMS = 8192, GU_CHL = 3, GU_CHH = 1;
    const int rem = NU % G, nranks = rem ? G - rem : G, nmine = NU / G;
    const bool full = rem && (int)blockIdx.x < rem;
    const int rank = full ? (int)blockIdx.x : (int)blockIdx.x - rem;
    const int nl = min(nranks * GU_CHL, GU_ITEMS / 16), nh = rem ? min(rem * GU_CHH, GU_ITEMS / 16 - nl) : 0;
    const int slot = rem ? rank % (nmine + 1) : nmine;
    S.i1 = slot; pg8::gemm_phase<false>(lds, g, S, E);
    if (full) conv_pool16(a, 0, nl + rank, rem, nl + nh); else conv_pool16(a, 0, rank, nranks, nl);
    S.i0 = slot; S.i1 = 1 << 24; pg8::gemm_phase<false>(lds, g, S, E);
    conv_dyn(a, 0, 16 * (nl + nh), GU_ITEMS, lds, (unsigned*)(ws + WS_CTL) + CW_Q);
}
__device__ __forceinline__ void ph_outproj(const Args& a, LAS unsigned char* lds, int G) {
    unsigned char* ws = a.ws;
    pg8::Gemm g{(const bf16*)(ws + WS_MIXED), (const bf16*)(ws + WS_WOUT), D};
    pg8::StaticOrder S; S.init(MTOK, D, D, G, (int)blockIdx.x);
    pg8::EpiOut E{(const bf16*)(ws + WS_XB), (bf16*)(ws + WS_HB), (unsigned char*)(ws + WS_HB8)};
    pg8::gemm_phase<false>(lds, g, S, E);
}
__device__ __forceinline__ void ph_gateup(const Args& a, LAS unsigned char* lds, int G) {
    unsigned char* ws = a.ws;
    const int T = moe_tables(a, lds);
    pg8::Gemm g{(const bf16*)(ws + WS_HB8), (const bf16*)(ws + WS_WGU), D / 2};
    pg8::MoeOrder S{(const LAS int*)(lds + LDSCTL_OFF + MISC_TSTART), (const LAS int*)(lds + LDSCTL_OFF + MISC_CNT), (const int*)(ws + WS_ROWTOK), T, G, moe_cpos((int)blockIdx.x, G), D / 2, 0, 1 << 24, moe_cpos_last((int)blockIdx.x, G)};
    pg8::EpiSwiglu E{(unsigned char*)(ws + WS_HID), (const float*)(ws + WS_ROWRS)};
    const int cp = moe_cpos_last((int)blockIdx.x, G);
    const int slot = conv_slot(4 * T, G, cp);
    if (slot >= 0) { S.i1 = slot; pg8::gemm_phase<true>(lds, g, S, E); conv_mine(a, 1, 4 * T, G, cp, 4096); S.i0 = slot; S.i1 = 1 << 24; pg8::gemm_phase<true>(lds, g, S, E); }
    else { pg8::gemm_phase<true>(lds, g, S, E); if (slot == -2) conv_mine(a, 1, 4 * T, G, cp, 4096); }
}
__device__ __forceinline__ void ph_down(const Args& a, LAS unsigned char* lds, int G) {
    unsigned char* ws = a.ws;
    const int T = ((const LAS int*)(lds + LDSCTL_OFF + MISC_TSTART))[NEXP];
    pg8::Gemm g{(const bf16*)(ws + WS_HID), (const bf16*)(ws + WS_WD), DEXP / 2};
    pg8::MoeOrder S{(const LAS int*)(lds + LDSCTL_OFF + MISC_TSTART), (const LAS int*)(lds + LDSCTL_OFF + MISC_CNT), nullptr, T, G, moe_cpos((int)blockIdx.x, G), DEXP / 2, 0, 1 << 24, moe_cpos_last((int)blockIdx.x, G)};
    pg8::EpiDown E{(unsigned char*)(ws + WS_YBUF), (const float*)(ws + WS_ROWGATE)};
    pg8::gemm_phase<true>(lds, g, S, E);
}
__device__ __forceinline__ void combine_store(float* o8, const u32x4& h, const u32x2& ya, const u32x2& yb) {
    const f32x2_t p0 = __builtin_amdgcn_cvt_pk_f32_fp8((int)ya.x, false), p1 = __builtin_amdgcn_cvt_pk_f32_fp8((int)ya.x, true), p2 = __builtin_amdgcn_cvt_pk_f32_fp8((int)ya.y, false), p3 = __builtin_amdgcn_cvt_pk_f32_fp8((int)ya.y, true);
    const f32x2_t r0 = __builtin_amdgcn_cvt_pk_f32_fp8((int)yb.x, false), r1 = __builtin_amdgcn_cvt_pk_f32_fp8((int)yb.x, true), r2 = __builtin_amdgcn_cvt_pk_f32_fp8((int)yb.y, false), r3 = __builtin_amdgcn_cvt_pk_f32_fp8((int)yb.y, true);
    f32x4 o0, o1;
    o0[0] = bflo(h.x) + (p0[0] + r0[0]) * Y8_INV; o0[1] = bfhi(h.x) + (p0[1] + r0[1]) * Y8_INV; o0[2] = bflo(h.y) + (p1[0] + r1[0]) * Y8_INV; o0[3] = bfhi(h.y) + (p1[1] + r1[1]) * Y8_INV;
    o1[0] = bflo(h.z) + (p2[0] + r2[0]) * Y8_INV; o1[1] = bfhi(h.z) + (p2[1] + r2[1]) * Y8_INV; o1[2] = bflo(h.w) + (p3[0] + r3[0]) * Y8_INV; o1[3] = bfhi(h.w) + (p3[1] + r3[1]) * Y8_INV;
    __builtin_nontemporal_store(o0, (f32x4*)o8); __builtin_nontemporal_store(o1, (f32x4*)(o8 + 4));
}
__device__ __forceinline__ void ph_combine(const Args& a, LAS unsigned char* lds, int G) {
    unsigned char* ws = a.ws;
    const int lane = threadIdx.x & 63, wave = threadIdx.x >> 6;
    const LAS int* tstart = (const LAS int*)(lds + LDSCTL_OFF + MISC_TSTART);
    const int* tokslot = (const int*)(ws + WS_TOKSLOT); const unsigned char* Y = ws + WS_YBUF; const bf16* HBp = (const bf16*)(ws + WS_HB);
    const int gw = blockIdx.x * 8 + wave, NGW = G * 8;
    for (int tb = gw; tb < MTOK; tb += 16 * NGW) {
        int mys0 = 0, mys1 = 0;
        { const int t = tb + (lane & 15) * NGW; if (t < MTOK) { const u32x2 sl = *(const u32x2*)(tokslot + 2 * t); mys0 = (int)sl.x; mys1 = (int)sl.y; } }
#pragma unroll
        for (int i = 0; i < 16; i += 2) {
            const int ta = tb + i * NGW, tc = tb + (i + 1) * NGW;
            if (ta >= MTOK) break;
            const bool two = tc < MTOK;
            const int a0 = __builtin_amdgcn_readlane(mys0, i), a1 = __builtin_amdgcn_readlane(mys1, i), c0 = __builtin_amdgcn_readlane(mys0, i + 1), c1 = __builtin_amdgcn_readlane(mys1, i + 1);
            const size_t ra0 = (size_t)(tstart[a0 >> 15] * 256 + (a0 & (ECAP - 1))), ra1 = (size_t)(tstart[a1 >> 15] * 256 + (a1 & (ECAP - 1)));
            const size_t rc0 = (size_t)(tstart[c0 >> 15] * 256 + (c0 & (ECAP - 1))), rc1 = (size_t)(tstart[c1 >> 15] * 256 + (c1 & (ECAP - 1)));
            u32x4 h[2][2]; u32x2 y0[2][2], y1[2][2];
#pragma unroll
            for (int j = 0; j < 2; ++j) { const int c = 8 * lane + 512 * j;
                h[0][j] = __builtin_nontemporal_load((const u32x4*)(HBp + (size_t)ta * D + c)); y0[0][j] = __builtin_nontemporal_load((const u32x2*)(Y + ra0 * D + c)); y1[0][j] = __builtin_nontemporal_load((const u32x2*)(Y + ra1 * D + c));
                h[1][j] = h[0][j]; y0[1][j] = y0[0][j]; y1[1][j] = y1[0][j];
                if (two) { h[1][j] = __builtin_nontemporal_load((const u32x4*)(HBp + (size_t)tc * D + c)); y0[1][j] = __builtin_nontemporal_load((const u32x2*)(Y + rc0 * D + c)); y1[1][j] = __builtin_nontemporal_load((const u32x2*)(Y + rc1 * D + c)); } }
#pragma unroll
            for (int j = 0; j < 2; ++j) { const int c = 8 * lane + 512 * j;
                combine_store(a.out + (size_t)ta * D + c, h[0][j], y0[0][j], y1[0][j]);
                if (two) combine_store(a.out + (size_t)tc * D + c, h[1][j], y0[1][j], y1[1][j]); }
        }
    }
}

#ifndef REP_PHASE
#define REP_PHASE -1
#endif
__global__ void __launch_bounds__(512, 2) hymba_fwd(Args a) {
    extern __shared__ __attribute__((aligned(16))) unsigned char lds_raw[];
    LAS unsigned char* lds = (LAS unsigned char*)lds_raw;
    const int tid = threadIdx.x, lane = tid & 63, wave = tid >> 6;
    const int G = gridDim.x;
    unsigned char* ws = a.ws;
    for (int u = tid; u < (LDS_BYTES - LDSCTL_OFF) / 4; u += 512) ((LAS unsigned*)(lds + LDSCTL_OFF))[u] = 0u;
    __syncthreads();
    XcdBarrier bar = xcd_barrier_post((unsigned*)(ws + WS_CTL) + CW_BAR, (volatile LAS unsigned*)(lds + LDSCTL_OFF + MISC_BAR));

    unsigned long long amp_t0 = 0, amp_t1 = 0;
    PH(0, p0_prologue(a, lds, G));
    PH(1, ph_inproj(a, lds, G, amp_t0, amp_t1));
    PH(2, p2_attn_conv(a, lds, G));
    PH(3, ph_outproj(a, lds, G));
    PH(4, p4_router(a, lds, G));
    PH(5, ph_gateup(a, lds, G));
    PH(6, ph_down(a, lds, G));
    if (AMP_PHASE == 7) amp_t0 = __builtin_amdgcn_s_memrealtime();
    ph_combine(a, lds, G);
    if (AMP_PHASE == 7) { xcd_barrier(bar); amp_t1 = __builtin_amdgcn_s_memrealtime(); }
    if (AMP_PHASE >= 0 && amp_t1 > amp_t0) { const unsigned long long span = (amp_t1 - amp_t0) * AMP_N, tw = __builtin_amdgcn_s_memrealtime(); while (__builtin_amdgcn_s_memrealtime() - tw < span) __builtin_amdgcn_s_sleep(8); }
#if REP_PHASE == 7
    xcd_barrier(bar); ph_combine(a, lds, G);
#endif
}

extern "C" void kernel_launch(void* const* d_in, const int* in_sizes, int n_in, void* d_out, int out_size, void* d_ws, size_t ws_size, hipStream_t stream) {
    static int grid = 0;
    if (grid == 0) {
        if (n_in != 20 || in_sizes[0] != MTOK * D || out_size != MTOK * D || ws_size < WS_END) {
            fprintf(stderr, "kernel_launch: unexpected shapes (n_in %d, in0 %d, out %d, ws %zu; need ws >= %zu); nothing launched\n", n_in, n_in > 0 ? in_sizes[0] : -1, out_size, ws_size, (size_t)WS_END);
            grid = -1; return; }
        int dev = 0, cus = 0;
        if (hipGetDevice(&dev) != hipSuccess || hipDeviceGetAttribute(&cus, hipDeviceAttributeMultiprocessorCount, dev) != hipSuccess) { grid = -1; return; }
        if (hipFuncSetAttribute((const void*)hymba_fwd, hipFuncAttributeMaxDynamicSharedMemorySize, LDS_BYTES) != hipSuccess) { fprintf(stderr, "kernel_launch: hipFuncSetAttribute failed\n"); grid = -1; return; }
        int per_cu = 0;
        if (hipOccupancyMaxActiveBlocksPerMultiprocessor(&per_cu, (const void*)hymba_fwd, 512, LDS_BYTES) != hipSuccess || per_cu < 1) { fprintf(stderr, "kernel_launch: occupancy query reports %d\n", per_cu); }
        (void)hipGetLastError();
        grid = cus;
    }
    if (grid < 0) return;
    if (hipMemsetAsync((char*)d_ws + WS_CTL, 0, CTL_BYTES, stream) != hipSuccess) return;
    Args a{};
    a.x = (const float*)d_in[0]; a.meta = (const float*)d_in[1]; a.rel_bias = (const float*)d_in[2]; a.mix_g = (const float*)d_in[3]; a.w_in = (const float*)d_in[4];
    a.q_g = (const float*)d_in[5]; a.k_g = (const float*)d_in[6]; a.sinks = (const float*)d_in[7]; a.conv_w = (const float*)d_in[8]; a.ga = (const float*)d_in[9];
    a.gc = (const float*)d_in[10]; a.w_out = (const float*)d_in[11]; a.ffn_g = (const float*)d_in[12]; a.w_gr = (const float*)d_in[13]; a.b_gr = (const float*)d_in[14];
    a.w_er = (const float*)d_in[15]; a.b_er = (const float*)d_in[16]; a.w_gate = (const float*)d_in[17]; a.w_up = (const float*)d_in[18]; a.w_down = (const float*)d_in[19];
    a.out = (float*)d_out; a.ws = (unsigned char*)d_ws;
    hipLaunchKernelGGL(hymba_fwd, dim3(grid), dim3(512), LDS_BYTES, stream, a);
}
```
